# Optimizing an MI355X kernel written in HIP

```python
import math, functools
import jax, jax.numpy as jnp
from jax import lax
import numpy as np

D_MODEL = 1024
BATCH = 32
SEQ = 2048
DEPTH = 2
DEC_BATCH = 8
DEC_SEQ = 2048
PAST_LEN = 128

N_MIXERS = 2
N_FOURIER_LAYERS = (DEPTH + 1) // 2
N_MLA_LAYERS = DEPTH // 2
N_FOURIER_GROUPS = 4
FOURIER_GROUP_DIM = D_MODEL // N_FOURIER_GROUPS
N_HEADS = 16
QK_NOPE_DIM = 64
QK_ROPE_DIM = 32
V_HEAD_DIM = 64
Q_LORA_RANK = D_MODEL // 4
KV_LORA_RANK = D_MODEL // 8
MLA_IN_DIM = Q_LORA_RANK + KV_LORA_RANK + QK_ROPE_DIM
ATTN_SCALE = (QK_NOPE_DIM + QK_ROPE_DIM) ** -0.5
ROPE_THETA = 10000.0
Q_BLOCK = 128
D_FF = ((8 * D_MODEL // 3 + 127) // 128) * 128
CONV_WIDTH = 3
EPS = 1e-6

kernel_name = "hybrid_fnet_mla_convffn_encoder"


def _rmsnorm(x, g):
    xf = x.astype(jnp.float32)
    y = xf * lax.rsqrt(jnp.mean(xf * xf, axis=-1, keepdims=True) + EPS)
    return (y * g.astype(jnp.float32)).astype(x.dtype)


def _fourier_mix(h, w_out):
    B, S, D = h.shape
    hg = h.astype(jnp.float32).reshape(B, S, N_FOURIER_GROUPS, FOURIER_GROUP_DIM)
    f = jnp.fft.fftn(hg, axes=(1, 3), norm="ortho").real
    return f.reshape(B, S, D).astype(h.dtype) @ w_out


def _rope_tables(S):
    inv = 1.0 / (ROPE_THETA ** (jnp.arange(0, QK_ROPE_DIM, 2, dtype=jnp.float32) / QK_ROPE_DIM))
    ang = jnp.arange(S, dtype=jnp.float32)[:, None] * inv[None, :]
    return jnp.cos(ang), jnp.sin(ang)


def _apply_rope(x, cos, sin):
    xf = x.astype(jnp.float32)
    half = QK_ROPE_DIM // 2
    x1, x2 = xf[..., :half], xf[..., half:]
    return jnp.concatenate([x1 * cos - x2 * sin, x2 * cos + x1 * sin], axis=-1).astype(x.dtype)


def _mla(h, w_in, g_q, g_kv, w_uq, w_ukv, w_o, cos, sin):
    B, S, _ = h.shape
    a = h @ w_in
    c_q = _rmsnorm(a[..., :Q_LORA_RANK], g_q)
    c_kv = _rmsnorm(a[..., Q_LORA_RANK:Q_LORA_RANK + KV_LORA_RANK], g_kv)
    k_rope = _apply_rope(a[..., Q_LORA_RANK + KV_LORA_RANK:], cos, sin)
    q = (c_q @ w_uq).reshape(B, S, N_HEADS, QK_NOPE_DIM + QK_ROPE_DIM)
    q_nope = q[..., :QK_NOPE_DIM]
    q_rope = _apply_rope(q[..., QK_NOPE_DIM:], cos[:, None, :], sin[:, None, :])
    kv = (c_kv @ w_ukv).reshape(B, S, N_HEADS, QK_NOPE_DIM + V_HEAD_DIM)
    k_nope, v = kv[..., :QK_NOPE_DIM], kv[..., QK_NOPE_DIM:]

    nb = S // Q_BLOCK

    def to_blocks(t):
        return jnp.moveaxis(t.reshape(B, nb, Q_BLOCK, *t.shape[2:]), 1, 0)

    def attend(blk):
        qn, qr = blk
        s = (jnp.einsum('bqhd,bkhd->bhqk', qn, k_nope, preferred_element_type=jnp.float32)
             + jnp.einsum('bqhd,bkd->bhqk', qr, k_rope, preferred_element_type=jnp.float32)) * ATTN_SCALE
        p = jax.nn.softmax(s, axis=-1).astype(v.dtype)
        return jnp.einsum('bhqk,bkhd->bqhd', p, v)

    o = lax.map(attend, (to_blocks(q_nope), to_blocks(q_rope)))
    o = jnp.moveaxis(o, 0, 1).reshape(B, S, N_HEADS * V_HEAD_DIM)
    return o @ w_o


def _conv_ffn(h, w_up, conv_w, conv_b, w_down):
    S = h.shape[1]
    u = h @ w_up
    pad = CONV_WIDTH // 2
    up = jnp.pad(u, ((0, 0), (pad, pad), (0, 0)))
    u = sum(up[:, k:k + S] * conv_w[k] for k in range(CONV_WIDTH)) + conv_b
    gate, val = u[..., :D_FF], u[..., D_FF:]
    return (jax.nn.silu(gate) * val) @ w_down


def _trunk(x, norm_mix, w_fourier_out, w_mla_in, g_mla_q, g_mla_kv, w_mla_uq, w_mla_ukv, w_mla_o,
           norm_ffn, w_ffn_up, conv_w, conv_b, w_ffn_down, norm_final):
    cos, sin = _rope_tables(x.shape[1])
    for i in range(DEPTH):
        h = _rmsnorm(x, norm_mix[i])
        j = i // N_MIXERS
        if i % N_MIXERS == 0:
            x = x + _fourier_mix(h, w_fourier_out[j])
        else:
            x = x + _mla(h, w_mla_in[j], g_mla_q[j], g_mla_kv[j], w_mla_uq[j], w_mla_ukv[j],
                         w_mla_o[j], cos, sin)
        h = _rmsnorm(x, norm_ffn[i])
        x = x + _conv_ffn(h, w_ffn_up[i], conv_w[i], conv_b[i], w_ffn_down[i])
    return _rmsnorm(x, norm_final)


def setup_inputs(seed: int = 0) -> dict:
    key = jax.random.key(seed)
    ks = jax.random.split(key, 18)
    f32 = jnp.float32

    def w(k, shape, fan_in):
        return jax.random.normal(k, shape, f32) * (fan_in ** -0.5)

    def gain(k, shape):
        return 1.0 + 0.01 * jax.random.normal(k, shape, f32)

    return {
        "x_prompt": jax.random.normal(ks[0], (BATCH, SEQ, D_MODEL), f32),
        "x_sample": jax.random.normal(ks[1], (DEC_BATCH, DEC_SEQ, D_MODEL), f32),
        "norm_mix": gain(ks[2], (DEPTH, D_MODEL)),
        "w_fourier_out": w(ks[3], (N_FOURIER_LAYERS, D_MODEL, D_MODEL), D_MODEL),
        "w_mla_in": w(ks[4], (N_MLA_LAYERS, D_MODEL, MLA_IN_DIM), D_MODEL),
        "g_mla_q": gain(ks[5], (N_MLA_LAYERS, Q_LORA_RANK)),
        "g_mla_kv": gain(ks[6], (N_MLA_LAYERS, KV_LORA_RANK)),
        "w_mla_uq": w(ks[7], (N_MLA_LAYERS, Q_LORA_RANK, N_HEADS * (QK_NOPE_DIM + QK_ROPE_DIM)), Q_LORA_RANK),
        "w_mla_ukv": w(ks[8], (N_MLA_LAYERS, KV_LORA_RANK, N_HEADS * (QK_NOPE_DIM + V_HEAD_DIM)), KV_LORA_RANK),
        "w_mla_o": w(ks[9], (N_MLA_LAYERS, N_HEADS * V_HEAD_DIM, D_MODEL), N_HEADS * V_HEAD_DIM),
        "norm_ffn": gain(ks[10], (DEPTH, D_MODEL)),
        "w_ffn_up": w(ks[11], (DEPTH, D_MODEL, 2 * D_FF), D_MODEL),
        "conv_w": w(ks[12], (DEPTH, CONV_WIDTH, 2 * D_FF), CONV_WIDTH),
        "conv_b": 0.01 * jax.random.normal(ks[13], (DEPTH, 2 * D_FF), f32),
        "w_ffn_down": w(ks[14], (DEPTH, D_FF, D_MODEL), D_FF),
        "norm_final": gain(ks[15], (D_MODEL,)),
    }


def reference(x_prompt, x_sample, norm_mix, w_fourier_out, w_mla_in, g_mla_q, g_mla_kv, w_mla_uq,
              w_mla_ukv, w_mla_o, norm_ffn, w_ffn_up, conv_w, conv_b, w_ffn_down, norm_final):
    y_prompt = _trunk(x_prompt, norm_mix, w_fourier_out, w_mla_in, g_mla_q, g_mla_kv, w_mla_uq,
                      w_mla_ukv, w_mla_o, norm_ffn, w_ffn_up, conv_w, conv_b, w_ffn_down, norm_final)
    y_sample = _trunk(x_sample, norm_mix, w_fourier_out, w_mla_in, g_mla_q, g_mla_kv, w_mla_uq,
                      w_mla_ukv, w_mla_o, norm_ffn, w_ffn_up, conv_w, conv_b, w_ffn_down, norm_final)
    return (y_prompt, y_sample)
```

```cpp
#include <hip/hip_runtime.h>
#include <hip/hip_cooperative_groups.h>
#include <cstdio>
#include <cstdint>
namespace cg = cooperative_groups;

#define LAS __attribute__((address_space(3)))
typedef unsigned short bf16_t;
typedef short bf16x8 __attribute__((ext_vector_type(8)));
typedef short s16x4 __attribute__((ext_vector_type(4)));
typedef float f32x4 __attribute__((ext_vector_type(4)));
typedef float f32x2 __attribute__((ext_vector_type(2)));
typedef float f32x16 __attribute__((ext_vector_type(16)));
typedef unsigned u32x4 __attribute__((ext_vector_type(4)));
typedef unsigned u32x2 __attribute__((ext_vector_type(2)));

constexpr int T = 81920, D = 1024, SEQ = 2048, NBATCH = 40, TP = 65536;
constexpr int FF = 2816, FF2 = 5632;
constexpr int NH = 16;
constexpr float EPS = 1e-6f;
constexpr size_t MiB = 1024ull * 1024ull;
constexpr size_t WS_WFO = 0, WS_WIN = 2 * MiB, WS_WUQ = 3 * MiB, WS_WK = 4 * MiB, WS_WV = 4 * MiB + 512 * 1024, WS_WO = 5 * MiB,
                 WS_WUP0 = 7 * MiB, WS_WUP1 = 18 * MiB, WS_WDN0 = 29 * MiB, WS_WDN1 = 35 * MiB, WS_DFTC = 41 * MiB, WS_ROPE = 42 * MiB,
                 WS_A2 = 43 * MiB, WS_SSP = 59 * MiB, WS_H = 64 * MiB, WS_BIG = 224 * MiB;
constexpr size_t WS_BAR = WS_ROPE + 896 * 1024;
constexpr size_t WS_RSTD = WS_ROPE + 512 * 1024;
constexpr size_t WS_Y1T = WS_BIG, WS_F = WS_BIG + 320 * MiB, WS_HS = WS_BIG + 480 * MiB;
constexpr int SEQH = 2304;
constexpr size_t WS_G = WS_BIG, WS_UH = WS_BIG + 440 * MiB;
constexpr size_t WS_Q = WS_BIG, WS_AA = WS_BIG, WS_KN = WS_BIG + 240 * MiB, WS_VT = WS_BIG + 400 * MiB, WS_CQ = WS_BIG + 560 * MiB, WS_CKV = WS_BIG + 600 * MiB,
                 WS_KR = WS_BIG + 620 * MiB, WS_O = WS_BIG + 625 * MiB;
constexpr size_t WS_END = WS_BIG + 785 * MiB;
constexpr int LDS_XB = 131072 + 16384;
constexpr int LDS_SIDE = 131072 + 16384 + 32;
constexpr int LDS_BYTES = LDS_SIDE + 2 * 6144;
constexpr int NTHREADS = 512;

struct Params {
    const float* in[16];
    float* out;
    unsigned char* ws;
    int ph_lo, ph_hi, coop, pad;
};

__device__ __forceinline__ int otid() { int t = threadIdx.x; asm volatile("" : "+v"(t)); return t; }
__device__ __forceinline__ int obid() { int b = blockIdx.x; asm volatile("" : "+s"(b)); return b; }
__device__ __forceinline__ unsigned cvt_pk_bf16(float lo, float hi) { unsigned r; asm volatile("v_cvt_pk_bf16_f32 %0, %1, %2" : "=v"(r) : "v"(lo), "v"(hi)); return r; }
__device__ __forceinline__ float bf2f(unsigned short b) { return __uint_as_float(((unsigned)b) << 16); }
__device__ __forceinline__ float bflo(unsigned w) { return __uint_as_float(w << 16); }
__device__ __forceinline__ float bfhi(unsigned w) { return __uint_as_float(w & 0xffff0000u); }
__device__ __forceinline__ const float* xrow0(const Params& p, int row) { return row < TP ? p.in[0] + (size_t)row * D : p.in[1] + (size_t)(row - TP) * D; }

constexpr int BM = 256, BK = 64, HALF = 128, HTB = HALF * BK * 2, NXCD = 8, WGM = 8;
__device__ __forceinline__ int lds_byte(int r, int c) { const int st = (r >> 4) * 2 + (c >> 5), rr = r & 15, cc = c & 31, ob = rr * 64 + cc * 2; return st * 1024 + (ob ^ (((ob >> 9) & 1) << 5)); }
__device__ __forceinline__ void stage_rc(int b, int& R, int& C) { const int st = b / 1024, sb = b % 1024, swz = sb ^ (((sb >> 9) & 1) << 5); R = (st >> 1) * 16 + swz / 64; C = (st & 1) * 32 + (swz % 64) / 2; }
__device__ __forceinline__ int perm32(int rho) { const int n = rho >> 4, i = rho & 15; return 8 * (i >> 2) + 4 * n + (i & 3); }

struct Unit { int pm, pn, bz; };
__device__ __forceinline__ bool y1t_sin(int vt) { return vt == 3 || vt == 4 || vt >= 7; }
enum { EM_PLAIN = 0, EM_Y1T = 1, EM_VT = 2, EM_GATE = 3, EM_RES0 = 4, EM_RES = 5 };
struct GemmJob { const bf16_t* A; const bf16_t* B; long bsA, bsB, bsO; void* O; const float* xp; const float* xs; float* ssp; bf16_t* xb; const float* cw; const float* cb; const bf16_t* uh; int lda, ldb, K, nM, nN, nB, emode, ldc, gather, rs16, crot; };

struct Sched {
    int nM, nN, nB, nwg, G, c;
    __device__ __forceinline__ void init(int nM_, int nN_, int nB_, int G_, int c_) { nM = nM_; nN = nN_; nB = nB_; nwg = nM * nN * nB; G = G_; c = c_; }
    __device__ __forceinline__ bool next(int i, Unit& u) const {
        const long L = (long)i * G + c; if (L >= nwg) return false;
        int wgid = (int)L; { const int q = nwg / NXCD, r = nwg % NXCD, xcd = wgid % NXCD, off = wgid / NXCD; wgid = (xcd < r ? xcd * (q + 1) : r * (q + 1) + (xcd - r) * q) + off; }
        const int nMf = nM * nB, nig = WGM * nN, gid = wgid / nig, fm = gid * WGM, gsz = (nMf - fm) < WGM ? (nMf - fm) : WGM;
        const int pmf = fm + ((wgid % nig) % gsz); u.pn = (wgid % nig) / gsz; u.bz = pmf / nM; u.pm = pmf % nM; return true;
    }
};

__device__ __forceinline__ float dpp_ror1(float src) { return __int_as_float(__builtin_amdgcn_update_dpp(0, __float_as_int(src), 0x121, 0xf, 0xf, true)); }
__device__ __forceinline__ float dpp_ror15(float src) { return __int_as_float(__builtin_amdgcn_update_dpp(0, __float_as_int(src), 0x12f, 0xf, 0xf, true)); }
__device__ __forceinline__ float dpp_up(float old, float src) { return __int_as_float(__builtin_amdgcn_update_dpp(__float_as_int(old), __float_as_int(src), 0x111, 0xf, 0xf, false)); }
__device__ __forceinline__ float dpp_dn(float old, float src) { return __int_as_float(__builtin_amdgcn_update_dpp(__float_as_int(old), __float_as_int(src), 0x101, 0xf, 0xf, false)); }
__device__ __forceinline__ void epilogue(const GemmJob& g, f32x4 (&acc)[2][2][4][2], const Unit& u, int wr, int wc, int fr_, int fq_, LAS unsigned char* lds, int par) {
    int fr = fr_, fq = fq_; asm volatile("" : "+v"(fr), "+v"(fq));
    if (g.emode == EM_GATE) {
        LAS unsigned char* E = lds + 131072;
        const LAS unsigned char* SD = lds + LDS_SIDE + par * 6144;
        float rsv[2][4];
#pragma unroll
        for (int ai = 0; ai < 2; ++ai)
#pragma unroll
            for (int m = 0; m < 4; ++m) rsv[ai][m] = *(const LAS float*)(SD + (ai * HALF + wr * 64 + m * 16 + fr) * 4);
        const int cl = wc * 32 + 8 * fq;
        const bool e0 = (fr == 0), e15 = (fr == 15);
#pragma unroll
        for (int ai = 0; ai < 2; ++ai)
#pragma unroll
            for (int m = 0; m < 4; ++m) {
                const float rstd = rsv[ai][m];
#pragma unroll
                for (int bj = 0; bj < 2; ++bj)
#pragma unroll
                    for (int n = 0; n < 2; ++n) acc[ai][bj][m][n] = acc[ai][bj][m][n] * rstd;
                if (e0 || e15) { const int er = 2 * (8 * ai + 4 * wr + m) + (e15 ? 1 : 0);
#pragma unroll
                    for (int bj = 0; bj < 2; ++bj) { const f32x4 v0 = acc[ai][bj][m][0], v1 = acc[ai][bj][m][1];
                        u32x4 w; w.x = cvt_pk_bf16(v0[0], v0[1]); w.y = cvt_pk_bf16(v0[2], v0[3]); w.z = cvt_pk_bf16(v1[0], v1[1]); w.w = cvt_pk_bf16(v1[2], v1[3]);
                        *(LAS u32x4*)(E + (er * 256 + bj * HALF + cl) * 2) = w; } }
            }
        asm volatile("s_waitcnt lgkmcnt(0)" ::: "memory"); __builtin_amdgcn_s_barrier(); asm volatile("" ::: "memory");
        const int pmq = u.pm & 7;
        u32x2 keep[2][4];
#pragma unroll
        for (int n = 0; n < 2; ++n) {
            const int f0 = u.pn * 128 + cl;
            f32x4 wg[3], wv[3];
#pragma unroll
            for (int k = 0; k < 3; ++k) { wg[k] = *(const LAS f32x4*)(SD + 1024 + k * 1024 + (cl + 4 * n) * 4); wv[k] = *(const LAS f32x4*)(SD + 1024 + k * 1024 + 512 + (cl + 4 * n) * 4); }
            const f32x4 bg = *(const LAS f32x4*)(SD + 4096 + (cl + 4 * n) * 4), bv = *(const LAS f32x4*)(SD + 4096 + 512 + (cl + 4 * n) * 4);
            bf16_t* gout = (bf16_t*)g.O + (size_t)(u.pm * BM + wr * 64 + fr) * FF + f0;
#pragma unroll
            for (int ai = 0; ai < 2; ++ai)
#pragma unroll
                for (int m = 0; m < 4; ++m) {
                    const int gi = 8 * ai + 4 * wr + m;
                    u32x2 wu[2], wd[2];
                    if (ai == 0 && m == 0 && wr == 0) {
#pragma unroll
                        for (int bj = 0; bj < 2; ++bj) { wu[bj] = (u32x2){0u, 0u}; if (pmq != 0) wu[bj] = *(const LAS u32x2*)(SD + 5120 + (bj * HALF + cl + 4 * n) * 2); }
                    } else {
#pragma unroll
                        for (int bj = 0; bj < 2; ++bj) wu[bj] = *(const LAS u32x2*)(E + ((2 * gi - 1) * 256 + bj * HALF + cl + 4 * n) * 2);
                    }
                    if (ai == 1 && m == 3 && wr == 1) {
#pragma unroll
                        for (int bj = 0; bj < 2; ++bj) { wd[bj] = (u32x2){0u, 0u}; if (pmq != 7) wd[bj] = *(const LAS u32x2*)(SD + 5632 + (bj * HALF + cl + 4 * n) * 2); }
                    } else {
#pragma unroll
                        for (int bj = 0; bj < 2; ++bj) wd[bj] = *(const LAS u32x2*)(E + ((2 * gi + 2) * 256 + bj * HALF + cl + 4 * n) * 2);
                    }
                    float o[4];
#pragma unroll
                    for (int j = 0; j < 4; ++j) {
                        const float cg_ = acc[ai][0][m][n][j], cv_ = acc[ai][1][m][n][j];
                        const unsigned pug = (j < 2) ? wu[0].x : wu[0].y, pdg = (j < 2) ? wd[0].x : wd[0].y, puv = (j < 2) ? wu[1].x : wu[1].y, pdv = (j < 2) ? wd[1].x : wd[1].y;
                        const float eug = (j & 1) ? bfhi(pug) : bflo(pug), edg = (j & 1) ? bfhi(pdg) : bflo(pdg), euv = (j & 1) ? bfhi(puv) : bflo(puv), edv = (j & 1) ? bfhi(pdv) : bflo(pdv);
                        const float ug = dpp_up(eug, cg_), dg = dpp_dn(edg, cg_);
                        const float uv = dpp_up(euv, cv_), dv = dpp_dn(edv, cv_);
                        const float gt = wg[0][j] * ug + wg[1][j] * cg_ + wg[2][j] * dg + bg[j];
                        const float vl = wv[0][j] * uv + wv[1][j] * cv_ + wv[2][j] * dv + bv[j];
                        o[j] = gt * __builtin_amdgcn_rcpf(1.0f + __builtin_amdgcn_exp2f(-1.4426950408889634f * gt)) * vl;
                    }
                    u32x2 ow; ow.x = cvt_pk_bf16(o[0], o[1]); ow.y = cvt_pk_bf16(o[2], o[3]);
                    if (n == 0) keep[ai][m] = ow;
                    else { u32x4 o4; o4.x = keep[ai][m].x; o4.y = keep[ai][m].y; o4.z = ow.x; o4.w = ow.y; *(u32x4*)(gout + (size_t)(ai * HALF + m * 16) * FF) = o4; }
                }
            asm volatile("" ::: "memory");
        }
        return;
    }
    if (g.emode <= EM_VT) {
        bf16_t* O = (bf16_t*)g.O; bf16_t* base;
        if (g.emode == EM_PLAIN) base = O + (size_t)u.bz * g.bsO + (size_t)u.pm * BM * g.ldc + (size_t)u.pn * BM;
        else if (g.emode == EM_Y1T) base = O + ((size_t)(u.pn / 9) * 1024 + (size_t)u.bz * 256) * SEQH + (size_t)(u.pn % 9) * 256;
        else base = O + ((size_t)(u.pn >> 3) * 1024 + (size_t)u.pm * 256) * 2048 + (size_t)(u.pn & 7) * 256;
        unsigned off = (unsigned)((wr * 64 + fr) * g.ldc + wc * 32 + 8 * fq) * 2u;
        const unsigned rstep = (unsigned)(16 * g.ldc) * 2u;
        float rsv[2][4];
#pragma unroll
        for (int ai = 0; ai < 2; ++ai)
#pragma unroll
            for (int m = 0; m < 4; ++m) rsv[ai][m] = 1.0f;
        if (g.ssp != nullptr) {
            if (g.rs16) {
#pragma unroll
                for (int ai = 0; ai < 2; ++ai)
#pragma unroll
                    for (int m = 0; m < 4; ++m) { const int i = u.pm * BM + ai * HALF + wr * 64 + m * 16 + fr, grow = 256 * (i >> 1) + 255 + (i & 1);
                        const f32x4* q4 = (const f32x4*)(g.ssp + (size_t)(grow < T ? grow : T - 1) * 16); const f32x4 a = q4[0], b = q4[1], c = q4[2], d = q4[3];
                        const float ss = ((a[0] + a[1]) + (a[2] + a[3])) + ((b[0] + b[1]) + (b[2] + b[3])) + ((c[0] + c[1]) + (c[2] + c[3])) + ((d[0] + d[1]) + (d[2] + d[3]));
                        rsv[ai][m] = rsqrtf(ss * (1.0f / D) + EPS); }
            } else { const float* sp = g.ssp + (u.pm * BM + wr * 64 + fr);
#pragma unroll
                for (int ai = 0; ai < 2; ++ai)
#pragma unroll
                    for (int m = 0; m < 4; ++m) rsv[ai][m] = sp[ai * HALF + m * 16]; } }
#pragma unroll
        for (int ai = 0; ai < 2; ++ai) {
#pragma unroll
            for (int m = 0; m < 4; ++m) {
                const float rstd = rsv[ai][m];
#pragma unroll
                for (int bj = 0; bj < 2; ++bj) { const f32x4 v0 = acc[ai][bj][m][0] * rstd, v1 = acc[ai][bj][m][1] * rstd;
                    u32x4 w; w.x = cvt_pk_bf16(v0[0], v0[1]); w.y = cvt_pk_bf16(v0[2], v0[3]); w.z = cvt_pk_bf16(v1[0], v1[1]); w.w = cvt_pk_bf16(v1[2], v1[3]);
                    *(u32x4*)((char*)base + off + bj * HALF * 2) = w; }
                off += rstep; }
            off += rstep * 4; }
    } else {
        const int row0 = u.pm * BM;
        bf16_t* xbase = g.xb + (size_t)row0 * D;
        const float* rbase = (row0 < TP ? g.xp + (size_t)row0 * D : g.xs + (size_t)(row0 - TP) * D);
        const unsigned off0 = (unsigned)((wr * 64 + fr) * D + u.pn * BM + wc * 32 + 8 * fq) * 2u;
        float* sp = g.ssp + (size_t)(row0 + wr * 64 + fr) * 16 + u.pn * 4 + wc;
#define RES_OFF(gi_) (off0 + (unsigned)(((gi_) >> 2) * HALF + ((gi_) & 3) * 16) * (unsigned)(D * 2))
#define RES_FIN(gi_, bj_, x0_, x1_) do { u32x4 w; w.x = cvt_pk_bf16(x0_[0], x0_[1]); w.y = cvt_pk_bf16(x0_[2], x0_[3]); w.z = cvt_pk_bf16(x1_[0], x1_[1]); w.w = cvt_pk_bf16(x1_[2], x1_[3]); \
            *(u32x4*)((char*)xbase + RES_OFF(gi_) + (bj_) * HALF * 2) = w; \
            _Pragma("unroll") for (int e_ = 0; e_ < 4; ++e_) { const float ya = bflo(w[e_]), yb = bfhi(w[e_]); ss += ya * ya + yb * yb; } } while (0)
        if (g.emode == EM_RES0) {
#pragma unroll
            for (int gp = 0; gp < 4; ++gp) {
                f32x4 rr[2][2][2];
#pragma unroll
                for (int h2 = 0; h2 < 2; ++h2)
#pragma unroll
                    for (int bj = 0; bj < 2; ++bj)
#pragma unroll
                        for (int n = 0; n < 2; ++n) rr[h2][bj][n] = *(const f32x4*)((const char*)rbase + 2 * (RES_OFF(2 * gp + h2) + bj * HALF * 2) + n * 16);
#pragma unroll
                for (int h2 = 0; h2 < 2; ++h2) {
                    const int gi = 2 * gp + h2, ai = gi >> 2, m = gi & 3;
                    float ss = 0.f;
#pragma unroll
                    for (int bj = 0; bj < 2; ++bj) { const f32x4 x0 = rr[h2][bj][0] + acc[ai][bj][m][0], x1 = rr[h2][bj][1] + acc[ai][bj][m][1]; RES_FIN(gi, bj, x0, x1); }
                    ss += __shfl_xor(ss, 16); ss += __shfl_xor(ss, 32);
                    if (fq == 0) sp[(size_t)(ai * HALF + m * 16) * 16] = ss;
                }
            }
        } else {
            u32x4 ra[4][2], rb[4][2];
#define RES_LOAD(dst, g0_) _Pragma("unroll") for (int m_ = 0; m_ < 4; ++m_) _Pragma("unroll") for (int bj = 0; bj < 2; ++bj) dst[m_][bj] = *(const u32x4*)((const char*)xbase + RES_OFF((g0_) + m_) + bj * HALF * 2)
#define RES_PROC(src, gi_) do { const int gi = (gi_), ai = gi >> 2, m = gi & 3; float ss = 0.f; \
                _Pragma("unroll") for (int bj = 0; bj < 2; ++bj) { const u32x4 rw = src[m][bj]; \
                    const f32x4 x0 = (f32x4){bflo(rw.x), bfhi(rw.x), bflo(rw.y), bfhi(rw.y)} + acc[ai][bj][m][0], x1 = (f32x4){bflo(rw.z), bfhi(rw.z), bflo(rw.w), bfhi(rw.w)} + acc[ai][bj][m][1]; \
                    RES_FIN(gi, bj, x0, x1); } \
                ss += __shfl_xor(ss, 16); ss += __shfl_xor(ss, 32); \
                if (fq == 0) sp[(size_t)(ai * HALF + m * 16) * 16] = ss; } while (0)
            RES_LOAD(ra, 0);
            RES_PROC(ra, 0); RES_PROC(ra, 1);
            RES_LOAD(rb, 4);
            RES_PROC(ra, 2); RES_PROC(ra, 3);
            RES_PROC(rb, 4); RES_PROC(rb, 5); RES_PROC(rb, 6); RES_PROC(rb, 7);
#undef RES_LOAD
#undef RES_PROC
        }
#undef RES_FIN
#undef RES_OFF
    }
}

__device__ __forceinline__ void gemm_phase(LAS unsigned char* lds, const GemmJob& g) {
    Sched S; S.init(g.nM, g.nN, g.nB, (int)gridDim.x, (obid() + g.crot) % (int)gridDim.x);
    int tid = threadIdx.x; asm volatile("" : "+v"(tid));
    const int wid = __builtin_amdgcn_readfirstlane(tid >> 6), lane = tid & 63, wr = wid >> 2, wc = wid & 3, fr = lane & 15, fq = lane >> 4;
    const int K = g.K, nt = K / BK;
    unsigned voffA[2], voffB[2];
#pragma unroll
    for (int i = 0; i < 2; ++i) { int R, C; stage_rc(tid * 16 + i * 8192, R, C); const int Rb = (R & ~31) + perm32(R & 31);
        const int Ra = g.gather ? ((R >> 1) * 256 + 255 + (R & 1)) : R;
        voffA[i] = (unsigned)(Ra * g.lda + C) * 2u; voffB[i] = (unsigned)(Rb * g.ldb + C) * 2u; }
    const size_t kstep = (size_t)(BK * 2);
    const size_t hstepA = (size_t)(g.gather ? 64 * 256 : HALF) * g.lda * 2, hstepB = (size_t)HALF * g.ldb * 2;
    const size_t tstepA = (size_t)(g.gather ? 128 * 256 : BM) * g.lda * 2;
    const unsigned ldsw = (unsigned)wid * 1024u;
    const int aoff = lds_byte(wr * 64 + fr, fq * 8), boff = lds_byte(wc * 32 + fr, fq * 8);
#define PG8_SA(b, h) (((b) * 2 + (h)) * HTB)
#define PG8_SB(b, h) ((4 + (b) * 2 + (h)) * HTB)
#define PG8_STAGE(bufoff, gbase, voff) do { _Pragma("unroll") for (int _i = 0; _i < 2; ++_i) \
        __builtin_amdgcn_global_load_lds((const unsigned*)((const char*)(gbase) + (voff)[_i]), (LAS unsigned*)(lds + (bufoff) + ldsw + _i * 8192), 16, 0, 0); } while (0)
#define PG8_LDA(dst, b, h) do { _Pragma("unroll") for (int m = 0; m < 4; ++m) _Pragma("unroll") for (int k = 0; k < 2; ++k) dst[m][k] = *(const LAS bf16x8*)(lds + PG8_SA(b, h) + aoff + m * 2048 + k * 1024); } while (0)
#define PG8_LDB(dst, b, h) do { _Pragma("unroll") for (int n = 0; n < 2; ++n) _Pragma("unroll") for (int k = 0; k < 2; ++k) dst[n][k] = *(const LAS bf16x8*)(lds + PG8_SB(b, h) + boff + n * 2048 + k * 1024); } while (0)
#define PG8_MMA(ai, bj, At, Bt) do { __builtin_amdgcn_s_setprio(1); _Pragma("unroll") for (int m = 0; m < 4; ++m) _Pragma("unroll") for (int n = 0; n < 2; ++n) _Pragma("unroll") for (int k = 0; k < 2; ++k) \
        acc[ai][bj][m][n] = __builtin_amdgcn_mfma_f32_16x16x32_bf16(Bt[n][k], At[m][k], acc[ai][bj][m][n], 0, 0, 0); __builtin_amdgcn_s_setprio(0); } while (0)
#define PG8_WAIT_V(n) asm volatile("s_waitcnt vmcnt(" #n ")" ::: "memory")
#define PG8_WAIT_L(n) asm volatile("s_waitcnt lgkmcnt(" #n ")" ::: "memory")
#define PG8_BAR __builtin_amdgcn_s_barrier()
#define PG8_SCHED __builtin_amdgcn_sched_barrier(0)
#define PG8_SIDE(U, PAR) do { if (g.emode == EM_GATE && wid < 6) { const int half_ = lane >> 5, l32_ = lane & 31; const char* gp_; \
        if (wid == 0) gp_ = (const char*)(g.ssp + (U).pm * BM) + lane * 16; \
        else if (wid <= 3) gp_ = (const char*)(g.cw + (size_t)(wid - 1) * FF2 + half_ * FF + (U).pn * 128) + l32_ * 16; \
        else if (wid == 4) gp_ = (const char*)(g.cb + half_ * FF + (U).pn * 128) + l32_ * 16; \
        else { const int hr_ = half_ ? 2 * (U).pm + 1 : ((U).pm > 0 ? 2 * ((U).pm - 1) : 0); gp_ = (const char*)(g.uh + (size_t)hr_ * FF2 + (U).pn * BM) + l32_ * 16; } \
        __builtin_amdgcn_global_load_lds((const unsigned*)gp_, (LAS unsigned*)(lds + LDS_SIDE + (PAR) * 6144 + wid * 1024), 16, 0, 0); } } while (0)
    Unit cur, nxt; int ui = 0;
    if (!S.next(0, cur)) return;
    PG8_SIDE(cur, 0);
    f32x4 acc[2][2][4][2];
#pragma unroll
    for (int a = 0; a < 2; ++a)
#pragma unroll
        for (int b = 0; b < 2; ++b)
#pragma unroll
            for (int m = 0; m < 4; ++m)
#pragma unroll
                for (int n = 0; n < 2; ++n) acc[a][b][m][n] = (f32x4){0.f, 0.f, 0.f, 0.f};
    bf16x8 At[4][2], B0[2][2], B1[2][2];
    const char* cA = (const char*)g.A + (size_t)cur.bz * g.bsA * 2 + (size_t)cur.pm * tstepA + ((g.emode == EM_Y1T && y1t_sin(cur.pn % 9)) ? (size_t)256 * 256 * 2 : (size_t)0);
    const char* cB = (const char*)g.B + ((size_t)cur.bz * g.bsB + (size_t)cur.pn * BM * g.ldb) * 2;
    PG8_STAGE(PG8_SB(0, 0), cB, voffB); PG8_STAGE(PG8_SB(0, 1), cB + hstepB, voffB); PG8_STAGE(PG8_SA(0, 0), cA, voffA); PG8_STAGE(PG8_SA(0, 1), cA + hstepA, voffA);
    if (wr == 1) PG8_BAR;
    PG8_WAIT_V(2); PG8_BAR;
    PG8_STAGE(PG8_SB(1, 0), cB + kstep, voffB); PG8_STAGE(PG8_SA(1, 0), cA + kstep, voffA); PG8_STAGE(PG8_SB(1, 1), cB + hstepB + kstep, voffB);
    PG8_WAIT_V(6); PG8_BAR;
    for (;;) {
        const bool has_next = S.next(ui + 1, nxt);
        const char* nA = has_next ? (const char*)g.A + (size_t)nxt.bz * g.bsA * 2 + (size_t)nxt.pm * tstepA + ((g.emode == EM_Y1T && y1t_sin(nxt.pn % 9)) ? (size_t)256 * 256 * 2 : (size_t)0) : cA;
        const char* nB = has_next ? (const char*)g.B + ((size_t)nxt.bz * g.bsB + (size_t)nxt.pn * BM * g.ldb) * 2 : cB;
        for (int t = 0; t < nt; t += 2) {
            const bool last = (t == nt - 2);
            const char* a1 = cA + (size_t)(t + 1) * kstep;
            const char* a2 = last ? nA : cA + (size_t)(t + 2) * kstep; const char* b2 = last ? nB : cB + (size_t)(t + 2) * kstep;
            const char* a3 = a2 + kstep; const char* b3 = b2 + kstep;
            PG8_LDB(B0, 0, 0); PG8_LDB(B1, 0, 1); PG8_SCHED; PG8_LDA(At, 0, 0); PG8_STAGE(PG8_SA(1, 1), a1 + hstepA, voffA);
            PG8_WAIT_V(8); PG8_WAIT_L(0); PG8_BAR; PG8_MMA(0, 0, At, B0); PG8_MMA(0, 1, At, B1); PG8_BAR; PG8_SCHED;
            PG8_LDA(At, 0, 1); PG8_STAGE(PG8_SB(0, 0), b2, voffB); PG8_STAGE(PG8_SB(0, 1), b2 + hstepB, voffB); PG8_STAGE(PG8_SA(0, 0), a2, voffA);
            PG8_WAIT_V(8); PG8_WAIT_L(0); PG8_BAR; PG8_MMA(1, 0, At, B0); PG8_MMA(1, 1, At, B1); PG8_BAR; PG8_SCHED;
            PG8_LDB(B0, 1, 0); PG8_LDB(B1, 1, 1); PG8_SCHED; PG8_LDA(At, 1, 0); PG8_STAGE(PG8_SA(0, 1), a2 + hstepA, voffA);
            PG8_WAIT_V(8); PG8_WAIT_L(0); PG8_BAR; PG8_MMA(0, 0, At, B0); PG8_MMA(0, 1, At, B1); PG8_BAR; PG8_SCHED;
            PG8_LDA(At, 1, 1); PG8_STAGE(PG8_SB(1, 0), b3, voffB); PG8_STAGE(PG8_SB(1, 1), b3 + hstepB, voffB); PG8_STAGE(PG8_SA(1, 0), a3, voffA);
            PG8_WAIT_V(8); PG8_WAIT_L(0); PG8_BAR; PG8_MMA(1, 0, At, B0); PG8_MMA(1, 1, At, B1); PG8_BAR; PG8_SCHED;
        }
        if (wr == 0) PG8_BAR;
        epilogue(g, acc, cur, wr, wc, fr, fq, lds, ui & 1);
        if (!has_next) break;
        PG8_SIDE(nxt, (ui + 1) & 1);
#pragma unroll
        for (int a = 0; a < 2; ++a)
#pragma unroll
            for (int b = 0; b < 2; ++b)
#pragma unroll
                for (int m = 0; m < 4; ++m)
#pragma unroll
                    for (int n = 0; n < 2; ++n) acc[a][b][m][n] = (f32x4){0.f, 0.f, 0.f, 0.f};
        cur = nxt; cA = nA; cB = nB; ++ui;
        if (wr == 1) PG8_BAR;
    }
    PG8_WAIT_V(0);
    PG8_BAR;
#undef PG8_SIDE
#undef PG8_SA
#undef PG8_SB
#undef PG8_STAGE
#undef PG8_LDA
#undef PG8_LDB
#undef PG8_MMA
#undef PG8_WAIT_V
#undef PG8_WAIT_L
#undef PG8_BAR
#undef PG8_SCHED
}

__device__ void transpose_w(const float* src, int K, int N, int ldsrc, bf16_t* dst, int Npad, int cmode, const float* kscale, float wscale, float* tile) {
    const int tidx_ = otid(), bidx_ = obid(); (void)tidx_; (void)bidx_;
    const int tid = tidx_, ntk = K / 64, ntn = Npad / 64;
    for (int t = bidx_; t < ntk * ntn; t += gridDim.x) {
        const int k0 = (t % ntk) * 64, n0 = (t / ntk) * 64;
#pragma unroll
        for (int i = 0; i < 2; ++i) { const int kk = (tid >> 4) + 32 * i, nn = (tid & 15) * 4;
            f32x4 v = (f32x4){0.f, 0.f, 0.f, 0.f};
            const int blk = n0 / 64, c0 = cmode == 0 ? n0 : cmode == 1 ? blk * 128 : cmode == 2 ? blk * 128 + 64 : ((blk >> 1) & 1) * FF + (blk >> 2) * 128 + (blk & 1) * 64;
            if (n0 + nn < N) v = *(const f32x4*)(src + (size_t)(k0 + kk) * ldsrc + c0 + nn);
            v = v * (kscale ? kscale[k0 + kk] * wscale : wscale);
            tile[kk * 65 + nn] = v[0]; tile[kk * 65 + nn + 1] = v[1]; tile[kk * 65 + nn + 2] = v[2]; tile[kk * 65 + nn + 3] = v[3]; }
        __syncthreads();
        { const int n = tid >> 3, kg = (tid & 7) * 8; u32x4 w;
          w.x = cvt_pk_bf16(tile[(kg + 0) * 65 + n], tile[(kg + 1) * 65 + n]); w.y = cvt_pk_bf16(tile[(kg + 2) * 65 + n], tile[(kg + 3) * 65 + n]);
          w.z = cvt_pk_bf16(tile[(kg + 4) * 65 + n], tile[(kg + 5) * 65 + n]); w.w = cvt_pk_bf16(tile[(kg + 6) * 65 + n], tile[(kg + 7) * 65 + n]);
          *(u32x4*)(dst + (size_t)(n0 + n) * K + k0 + kg) = w; }
        __syncthreads();
    }
}

__device__ void rmsnorm_pass(const Params& p, const int MODE, const float* gain, bf16_t* H) {
    const int tidx_ = otid(), bidx_ = obid();
    const int lane = tidx_ & 63, wid = tidx_ >> 6;
    if (MODE == 0) {
        bf16_t* HS = (bf16_t*)(p.ws + WS_HS);
        f32x4 g4[4];
#pragma unroll
        for (int i = 0; i < 4; ++i) g4[i] = *(const f32x4*)(gain + (lane + 64 * i) * 4);
        for (int task = bidx_ * 8 + wid; task < NBATCH * 768; task += gridDim.x * 8) {
            const int b = task / 768, sI = task % 768;
            bf16_t* hb = HS + (size_t)b * SEQH * D;
            const u32x2 z2 = (u32x2){0u, 0u};
            if (sI > 512) {
#pragma unroll
                for (int i = 0; i < 4; ++i) *(u32x2*)(hb + (size_t)sI * D + (lane + 64 * i) * 4) = z2;
                continue; }
            const bool edge = (sI == 0 || sI == 512);
            const float* q0 = xrow0(p, b * SEQ + sI); const float* q1 = xrow0(p, b * SEQ + sI + 1024);
            const float* q2 = xrow0(p, b * SEQ + (edge ? sI : 1024 - sI)); const float* q3 = xrow0(p, b * SEQ + (edge ? sI + 1024 : 2048 - sI));
            f32x4 v0[4], v1[4], v2[4], v3[4]; float s0 = 0.f, s1 = 0.f, s2 = 0.f, s3 = 0.f;
#pragma unroll
            for (int i = 0; i < 4; ++i) { const int e0 = (lane + 64 * i) * 4; v0[i] = *(const f32x4*)(q0 + e0); v1[i] = *(const f32x4*)(q1 + e0); v2[i] = *(const f32x4*)(q2 + e0); v3[i] = *(const f32x4*)(q3 + e0);
                s0 += v0[i][0] * v0[i][0] + v0[i][1] * v0[i][1] + v0[i][2] * v0[i][2] + v0[i][3] * v0[i][3]; s1 += v1[i][0] * v1[i][0] + v1[i][1] * v1[i][1] + v1[i][2] * v1[i][2] + v1[i][3] * v1[i][3];
                s2 += v2[i][0] * v2[i][0] + v2[i][1] * v2[i][1] + v2[i][2] * v2[i][2] + v2[i][3] * v2[i][3]; s3 += v3[i][0] * v3[i][0] + v3[i][1] * v3[i][1] + v3[i][2] * v3[i][2] + v3[i][3] * v3[i][3]; }
#pragma unroll
            for (int o = 32; o >= 1; o >>= 1) { s0 += __shfl_xor(s0, o); s1 += __shfl_xor(s1, o); s2 += __shfl_xor(s2, o); s3 += __shfl_xor(s3, o); }
            const float r0 = rsqrtf(s0 * (1.0f / D) + EPS), r1 = rsqrtf(s1 * (1.0f / D) + EPS), r2 = edge ? 0.f : rsqrtf(s2 * (1.0f / D) + EPS), r3 = edge ? 0.f : rsqrtf(s3 * (1.0f / D) + EPS);
#pragma unroll
            for (int i = 0; i < 4; ++i) { const int e0 = (lane + 64 * i) * 4;
                const f32x4 h0 = v0[i] * r0 * g4[i], h1 = v1[i] * r1 * g4[i], h2 = v2[i] * r2 * g4[i], h3 = v3[i] * r3 * g4[i];
                const f32x4 xe = h0 + h1, xo = h0 - h1, ye = h2 + h3, yo = h2 - h3;
                const f32x4 ec = xe + ye, es = xe - ye, oc = xo - yo, os = xo + yo;
#define HS_ST(row_, val_) do { u32x2 w_; w_.x = cvt_pk_bf16(val_[0], val_[1]); w_.y = cvt_pk_bf16(val_[2], val_[3]); *(u32x2*)(hb + (size_t)(row_) * D + e0) = w_; } while (0)
                HS_ST(sI, ec);
                if (sI == 0) { *(u32x2*)(hb + (size_t)768 * D + e0) = z2; HS_ST(1280, oc); }
                else if (sI == 512) { HS_ST(1791 + 512, os); }
                else { HS_ST(768 + sI, es); HS_ST(1280 + sI, oc); HS_ST(1791 + sI, os); }
#undef HS_ST
            }
        }
    } else {
        f32x4 g4[2][2];
#pragma unroll
        for (int i = 0; i < 2; ++i) { g4[i][0] = *(const f32x4*)(gain + i * 512 + lane * 8); g4[i][1] = *(const f32x4*)(gain + i * 512 + lane * 8 + 4); }
        for (int row0 = bidx_ * 8 + wid; row0 < T; row0 += gridDim.x * 8 * 4) {
          u32x4 wq[4][2];
#pragma unroll
          for (int r = 0; r < 4; ++r)
#pragma unroll
            for (int i = 0; i < 2; ++i) { const int rr_ = row0 + r * (int)gridDim.x * 8; wq[r][i] = *(const u32x4*)(H + (size_t)(rr_ < T ? rr_ : T - 1) * D + i * 512 + lane * 8); }
#pragma unroll
          for (int r = 0; r < 4; ++r) {
            const int row = row0 + r * (int)gridDim.x * 8;
            if (row >= T) continue;
            float v[2][8]; float ss = 0.f;
#pragma unroll
            for (int i = 0; i < 2; ++i) { const u32x4 w = wq[r][i];
#pragma unroll
                for (int q = 0; q < 4; ++q) { v[i][2 * q] = bflo(w[q]); v[i][2 * q + 1] = bfhi(w[q]); ss += v[i][2 * q] * v[i][2 * q] + v[i][2 * q + 1] * v[i][2 * q + 1]; } }
#pragma unroll
            for (int o = 32; o >= 1; o >>= 1) ss += __shfl_xor(ss, o);
            const float rstd = rsqrtf(ss * (1.0f / D) + EPS);
            float* op = p.out + (size_t)row * D;
#pragma unroll
            for (int i = 0; i < 2; ++i) {
                const f32x4 o0 = (f32x4){v[i][0], v[i][1], v[i][2], v[i][3]} * rstd * g4[i][0], o1 = (f32x4){v[i][4], v[i][5], v[i][6], v[i][7]} * rstd * g4[i][1];
                *(f32x4*)(op + i * 512 + lane * 8) = o0; *(f32x4*)(op + i * 512 + lane * 8 + 4) = o1; }
          }
        }
    }
}

__device__ void gen_tables(const Params& p) {
    const int tidx_ = otid(), bidx_ = obid(); (void)tidx_; (void)bidx_;
    const size_t gtid = (size_t)bidx_ * NTHREADS + tidx_, gsz = (size_t)gridDim.x * NTHREADS;
    bf16_t* A2 = (bf16_t*)(p.ws + WS_A2);
    const float sc2 = 0.02209708691207961f;
    for (size_t e = gtid; e < (size_t)1024 * 1280 / 8; e += gsz) {
        const int k = (int)(e / 160), c0 = (int)(e % 160) * 8;
        float v[8];
#pragma unroll
        for (int j = 0; j < 8; ++j) { const int c = c0 + j, sp = c >= 768 ? c - 768 : c; const int ph = (k * sp) & 1023; float sn, cn; sincospif((float)ph * (1.0f / 512.0f), &sn, &cn);
            v[j] = c <= 512 ? cn * sc2 : (c < 768 ? 0.f : -sn * sc2); }
        u32x4 w; w.x = cvt_pk_bf16(v[0], v[1]); w.y = cvt_pk_bf16(v[2], v[3]); w.z = cvt_pk_bf16(v[4], v[5]); w.w = cvt_pk_bf16(v[6], v[7]);
        *(u32x4*)(A2 + e * 8) = w;
    }
    bf16_t* A2o = A2 + (size_t)1024 * 1280;
    for (size_t e = gtid; e < (size_t)1024 * 1024 / 8; e += gsz) {
        const int k = (int)(e / 128), c0 = (int)(e % 128) * 8;
        float v[8];
#pragma unroll
        for (int j = 0; j < 8; ++j) { const int c = c0 + j, sp = c >= 512 ? c - 511 : c; const int ph = ((2 * k + 1) * sp) & 2047; float sn, cn; sincospif((float)ph * (1.0f / 1024.0f), &sn, &cn);
            v[j] = c < 512 ? cn * sc2 : -sn * sc2; }
        u32x4 w; w.x = cvt_pk_bf16(v[0], v[1]); w.y = cvt_pk_bf16(v[2], v[3]); w.z = cvt_pk_bf16(v[4], v[5]); w.w = cvt_pk_bf16(v[6], v[7]);
        *(u32x4*)(A2o + e * 8) = w;
    }
    bf16_t* Dc = (bf16_t*)(p.ws + WS_DFTC);
    for (size_t e = gtid; e < (size_t)512 * 256 / 8; e += gsz) {
        const int r = (int)(e / 32), c0 = (int)(e % 32) * 8, cs = r >> 8, m = r & 255;
        float v[8];
#pragma unroll
        for (int j = 0; j < 8; ++j) { const int ph = (m * (c0 + j)) & 255; float sn, cn; sincospif((float)ph * (1.0f / 128.0f), &sn, &cn); v[j] = (cs ? sn : cn) * 0.0625f; }
        u32x4 w; w.x = cvt_pk_bf16(v[0], v[1]); w.y = cvt_pk_bf16(v[2], v[3]); w.z = cvt_pk_bf16(v[4], v[5]); w.w = cvt_pk_bf16(v[6], v[7]);
        *(u32x4*)(Dc + e * 8) = w;
    }
    f32x2* rope = (f32x2*)(p.ws + WS_ROPE);
    for (size_t e = gtid; e < (size_t)2048 * 16; e += gsz) {
        const int s = (int)(e >> 4), i = (int)(e & 15);
        const float inv = 1.0f / powf(10000.0f, (float)(2 * i) / 32.0f);
        const float ang = (float)s * inv;
        rope[e] = (f32x2){cosf(ang), sinf(ang)};
    }
}

__device__ void mla_mid_pass(const Params& p) {
    const int tidx_ = otid(), bidx_ = obid(); (void)tidx_; (void)bidx_;
    const bf16_t* AA = (const bf16_t*)(p.ws + WS_AA);
    bf16_t* CQ = (bf16_t*)(p.ws + WS_CQ); bf16_t* CKV = (bf16_t*)(p.ws + WS_CKV); bf16_t* KR = (bf16_t*)(p.ws + WS_KR);
    const f32x2* rope = (const f32x2*)(p.ws + WS_ROPE);
    const int lane = tidx_ & 63, wid = tidx_ >> 6;
    float gn[8];
#pragma unroll
    for (int j = 0; j < 8; ++j) gn[j] = lane < 32 ? p.in[5][lane * 8 + j] : (lane < 48 ? p.in[6][(lane - 32) * 8 + j] : 1.0f);
    for (int row0 = bidx_ * 8 + wid; row0 < T; row0 += gridDim.x * 8 * 4) {
        u32x4 wq[4];
#pragma unroll
        for (int r = 0; r < 4; ++r) { const int rr_ = row0 + r * (int)gridDim.x * 8; wq[r] = *(const u32x4*)(AA + (size_t)(rr_ < T ? rr_ : T - 1) * 512 + lane * 8); }
#pragma unroll
        for (int r = 0; r < 4; ++r) {
        const int row = row0 + r * (int)gridDim.x * 8; const u32x4 w = wq[r];
        if (row >= T) continue;
        float v[8];
#pragma unroll
        for (int q = 0; q < 4; ++q) { v[2 * q] = bflo(w[q]); v[2 * q + 1] = bfhi(w[q]); }
        float ss = 0.f;
#pragma unroll
        for (int j = 0; j < 8; ++j) ss += v[j] * v[j];
#pragma unroll
        for (int o = 8; o >= 1; o >>= 1) ss += __shfl_xor(ss, o);
        const float ss32 = ss + __shfl_xor(ss, 16);
        float pv[8];
#pragma unroll
        for (int j = 0; j < 8; ++j) pv[j] = __shfl_xor(v[j], 2);
        if (lane < 32) { const float rstd = rsqrtf(ss32 * (1.0f / 256.0f) + EPS); u32x4 o;
#pragma unroll
            for (int q = 0; q < 4; ++q) o[q] = cvt_pk_bf16(v[2 * q] * rstd * gn[2 * q], v[2 * q + 1] * rstd * gn[2 * q + 1]);
            *(u32x4*)(CQ + (size_t)row * 256 + lane * 8) = o;
        } else if (lane < 48) { const float rstd = rsqrtf(ss * (1.0f / 128.0f) + EPS); u32x4 o;
#pragma unroll
            for (int q = 0; q < 4; ++q) o[q] = cvt_pk_bf16(v[2 * q] * rstd * gn[2 * q], v[2 * q + 1] * rstd * gn[2 * q + 1]);
            *(u32x4*)(CKV + (size_t)row * 128 + (lane - 32) * 8) = o;
        } else if (lane < 52) { const int s = row & (SEQ - 1), l4 = lane - 48, i0 = (l4 & 1) * 8; const bool second = l4 >= 2; float o[8];
#pragma unroll
            for (int j = 0; j < 8; ++j) { const f32x2 cs = rope[s * 16 + i0 + j]; o[j] = second ? (v[j] * cs.x + pv[j] * cs.y) : (v[j] * cs.x - pv[j] * cs.y); }
            u32x4 ow;
#pragma unroll
            for (int q = 0; q < 4; ++q) ow[q] = cvt_pk_bf16(o[2 * q], o[2 * q + 1]);
            *(u32x4*)(KR + (size_t)row * 32 + l4 * 8) = ow;
        }
        }
    }
}

constexpr int KROWB = 208, VROWB = 136, KBUFB = 64 * KROWB, VBUFB = 64 * VROWB;
__device__ __forceinline__ int crow(int r, int hi) { return (r & 3) + 8 * (r >> 2) + 4 * hi; }
__device__ __forceinline__ bf16x8 pack8(const f32x16& x, int s) {
    u32x4 pk; pk.x = cvt_pk_bf16(x[8 * s], x[8 * s + 1]); pk.y = cvt_pk_bf16(x[8 * s + 2], x[8 * s + 3]); pk.z = cvt_pk_bf16(x[8 * s + 4], x[8 * s + 5]); pk.w = cvt_pk_bf16(x[8 * s + 6], x[8 * s + 7]);
    return __builtin_bit_cast(bf16x8, pk);
}
__device__ void attn_phase(const Params& p, LAS unsigned char* lds) {
    const int tidx_ = otid(), bidx_ = obid(); (void)tidx_; (void)bidx_;
    const bf16_t* Q = (const bf16_t*)(p.ws + WS_Q); const bf16_t* KN = (const bf16_t*)(p.ws + WS_KN); const bf16_t* VT = (const bf16_t*)(p.ws + WS_VT);
    const bf16_t* KR = (const bf16_t*)(p.ws + WS_KR); bf16_t* O = (bf16_t*)(p.ws + WS_O);
    const f32x2* rope = (const f32x2*)(p.ws + WS_ROPE);
    const int tid = tidx_, lane = tid & 63, r32 = lane & 31, hi = lane >> 5, wid = tid >> 6;
    const int G = gridDim.x, bx = bidx_, vcu = (G % 8 == 0) ? (bx % 8) * (G / 8) + bx / 8 : bx;
    constexpr int NUNITS = NBATCH * NH * 8, NKT = SEQ / 64;
    for (int u = vcu; u < NUNITS; u += G) {
        const int bh = u >> 3, qb = u & 7, b = bh >> 4, h = bh & 15;
        const int spos = qb * 256 + wid * 32 + r32; const size_t tq = (size_t)b * SEQ + spos;
        bf16x8 qf[6];
#pragma unroll
        for (int d0 = 0; d0 < 6; ++d0) qf[d0] = *(const bf16x8*)(Q + tq * 1536 + h * 96 + d0 * 16 + hi * 8);
        {
            bf16x8 a = qf[4], c = qf[5]; bf16x8 na, nc;
#pragma unroll
            for (int j = 0; j < 8; j += 2) {
                const f32x2 cs0 = rope[spos * 16 + hi * 8 + j], cs1 = rope[spos * 16 + hi * 8 + j + 1];
                const float x10 = bf2f((unsigned short)a[j]), x11 = bf2f((unsigned short)a[j + 1]), x20 = bf2f((unsigned short)c[j]), x21 = bf2f((unsigned short)c[j + 1]);
                const unsigned w1 = cvt_pk_bf16(x10 * cs0.x - x20 * cs0.y, x11 * cs1.x - x21 * cs1.y);
                const unsigned w2 = cvt_pk_bf16(x20 * cs0.x + x10 * cs0.y, x21 * cs1.x + x11 * cs1.y);
                na[j] = (short)(w1 & 0xffff); na[j + 1] = (short)(w1 >> 16); nc[j] = (short)(w2 & 0xffff); nc[j + 1] = (short)(w2 >> 16);
            }
            qf[4] = na; qf[5] = nc;
        }
        float mref = 0.f, lrun = 0.f;
        f32x16 negm;
#pragma unroll
        for (int i = 0; i < 16; ++i) negm[i] = 0.f;
        constexpr float THR = 8.0f;
        f32x16 o0, o1;
#pragma unroll
        for (int i = 0; i < 16; ++i) { o0[i] = 0.f; o1[i] = 0.f; }
        const char* kbase = (const char*)(KN + (size_t)b * SEQ * 1024 + h * 64);
        const char* rbase_ = (const char*)(KR + (size_t)b * SEQ * 32);
        const char* vbase = (const char*)(VT + ((size_t)b * 1024 + h * 64) * 2048);
        const unsigned klane = (unsigned)(((tid >> 3) * 1024 + (tid & 7) * 8) * 2), rlane = (unsigned)(((tid >> 2) * 32 + (tid & 3) * 8) * 2), vlane = (unsigned)(((tid >> 3) * 2048 + (tid & 7) * 8) * 2);
#define KSRC(t_) (kbase + (size_t)(t_) * (64 * 1024 * 2) + klane)
#define RSRC(t_) (rbase_ + (size_t)(t_) * (64 * 32 * 2) + rlane)
#define VSRC(t_) (vbase + (size_t)(t_) * (64 * 2) + vlane)
        const int kdst = (tid >> 3) * KROWB + (tid & 7) * 16, rdst = (tid >> 2) * KROWB + 128 + (tid & 3) * 16, vdst = (tid >> 3) * VROWB + (tid & 7) * 16;
        LAS unsigned char* Kr = lds;
        LAS unsigned char* Vr = lds + 2 * KBUFB;
        u32x4 skA, srA, svA, skB, srB, svB;
        skA = *(const u32x4*)KSRC(0); if (tid < 256) srA = *(const u32x4*)RSRC(0);
        *(LAS u32x4*)(Kr + kdst) = skA; if (tid < 256) *(LAS u32x4*)(Kr + rdst) = srA;
        skA = *(const u32x4*)KSRC(1); if (tid < 256) srA = *(const u32x4*)RSRC(1); svA = *(const u32x4*)VSRC(0);
        skB = *(const u32x4*)KSRC(2); if (tid < 256) srB = *(const u32x4*)RSRC(2); svB = *(const u32x4*)VSRC(1);
        asm volatile("s_waitcnt lgkmcnt(0)\n\ts_barrier" ::: "memory");
        f32x16 pa0, pa1, pb0, pb1;
        {
#pragma unroll
            for (int i = 0; i < 16; ++i) { pa0[i] = negm[i]; pa1[i] = negm[i]; }
#pragma unroll
            for (int d0 = 0; d0 < 6; ++d0) {
                const bf16x8 a0 = *(const LAS bf16x8*)(Kr + r32 * KROWB + (16 * d0 + 8 * hi) * 2);
                const bf16x8 a1 = *(const LAS bf16x8*)(Kr + (32 + r32) * KROWB + (16 * d0 + 8 * hi) * 2);
                pa0 = __builtin_amdgcn_mfma_f32_32x32x16_bf16(a0, qf[d0], pa0, 0, 0, 0);
                pa1 = __builtin_amdgcn_mfma_f32_32x32x16_bf16(a1, qf[d0], pa1, 0, 0, 0);
            }
        }
#define ATT_ITER(kt, SK, SR, SV, PC0, PC1, PN0, PN1) do { \
              \
            LAS unsigned char* Kn = Kr + ((kt + 1) & 1) * KBUFB; LAS unsigned char* Vb = Vr + (kt & 1) * VBUFB; \
            *(LAS u32x4*)(Kn + kdst) = SK; \
            if (tid < 256) *(LAS u32x4*)(Kn + rdst) = SR; \
            *(LAS u32x2*)(Vb + vdst) = (u32x2){SV.x, SV.y}; *(LAS u32x2*)(Vb + vdst + 8) = (u32x2){SV.z, SV.w}; \
            asm volatile("s_waitcnt lgkmcnt(0)\n\ts_barrier" ::: "memory"); \
            { const int k2 = (kt + 3 < NKT) ? kt + 3 : NKT - 1, v1 = (kt + 2 < NKT) ? kt + 2 : NKT - 1;       \
              SK = *(const u32x4*)KSRC(k2); SV = *(const u32x4*)VSRC(v1); if (tid < 256) SR = *(const u32x4*)RSRC(k2); } \
              \
            float mx = fmaxf(fmaxf(PC0[0], PC0[1]), PC1[0]); \
_Pragma("unroll") \
            for (int i = 2; i < 16; i += 2) mx = fmaxf(fmaxf(mx, PC0[i]), PC0[i + 1]); \
_Pragma("unroll") \
            for (int i = 1; i < 16; i += 2) mx = fmaxf(fmaxf(mx, PC1[i]), PC1[i + 1 < 16 ? i + 1 : 0]); \
            { const auto rr = __builtin_amdgcn_permlane32_swap(__float_as_uint(mx), __float_as_uint(mx), false, false); mx = fmaxf(__uint_as_float(rr[0]), __uint_as_float(rr[1])); } \
            if (kt == 0 || __builtin_amdgcn_ballot_w64(mx > THR) != 0ull) {       \
                const float dm = (kt == 0) ? mx : fmaxf(mx, 0.f), alpha = (kt == 0) ? 1.0f : __builtin_amdgcn_exp2f(-dm);     \
                mref += dm; lrun *= alpha; \
_Pragma("unroll") \
                for (int i = 0; i < 16; ++i) { PC0[i] -= dm; PC1[i] -= dm; negm[i] = -mref; } \
_Pragma("unroll") \
                for (int i = 0; i < 16; ++i) { o0[i] *= alpha; o1[i] *= alpha; } \
            } \
              \
_Pragma("unroll") \
            for (int dh3 = 0; dh3 < 2; ++dh3) {         \
                bf16x8 kfa[3], kfb[3]; \
_Pragma("unroll") \
                for (int d1 = 0; d1 < 3; ++d1) { const int d0 = 3 * dh3 + d1; kfa[d1] = *(const LAS bf16x8*)(Kn + r32 * KROWB + (16 * d0 + 8 * hi) * 2); kfb[d1] = *(const LAS bf16x8*)(Kn + (32 + r32) * KROWB + (16 * d0 + 8 * hi) * 2); } \
                __builtin_amdgcn_sched_barrier(0); \
_Pragma("unroll") \
                for (int d1 = 0; d1 < 3; ++d1) { const int d0 = 3 * dh3 + d1; \
                    PN0 = __builtin_amdgcn_mfma_f32_32x32x16_bf16(kfa[d1], qf[d0], d0 == 0 ? negm : PN0, 0, 0, 0);     \
                    PN1 = __builtin_amdgcn_mfma_f32_32x32x16_bf16(kfb[d1], qf[d0], d0 == 0 ? negm : PN1, 0, 0, 0); \
                } \
            } \
            f32x16 e0, e1; \
_Pragma("unroll") \
            for (int i = 0; i < 16; ++i) { e0[i] = __builtin_amdgcn_exp2f(PC0[i]); e1[i] = __builtin_amdgcn_exp2f(PC1[i]); } \
            { const f32x16 es = e0 + e1;        \
              typedef float f32x8_ __attribute__((ext_vector_type(8))); \
              const f32x8_ s8 = __builtin_shufflevector(es, es, 0, 1, 2, 3, 4, 5, 6, 7) + __builtin_shufflevector(es, es, 8, 9, 10, 11, 12, 13, 14, 15); \
              const f32x4 s4 = __builtin_shufflevector(s8, s8, 0, 1, 2, 3) + __builtin_shufflevector(s8, s8, 4, 5, 6, 7); \
              const f32x2 s2 = __builtin_shufflevector(s4, s4, 0, 1) + __builtin_shufflevector(s4, s4, 2, 3); \
              lrun += s2[0] + s2[1]; } \
              \
_Pragma("unroll") \
            for (int kh = 0; kh < 2; ++kh) \
_Pragma("unroll") \
                for (int s = 0; s < 2; ++s) { \
                    const bf16x8 pf = pack8(kh ? e1 : e0, s); \
                      \
                    s16x4 vl0, vh0, vl1, vh1; \
                    { const unsigned va = (unsigned)(size_t)(Vb + r32 * VROWB + hi * 8 + kh * 64 + s * 32); \
                      asm volatile("ds_read_b64 %0, %4\n\tds_read_b64 %1, %4 offset:16\n\tds_read_b64 %2, %4 offset:4352\n\tds_read_b64 %3, %4 offset:4368\n\ts_waitcnt lgkmcnt(0)" \
                                   : "=&v"(vl0), "=&v"(vh0), "=&v"(vl1), "=&v"(vh1) : "v"(va)); } \
                    o0 = __builtin_amdgcn_mfma_f32_32x32x16_bf16(__builtin_shufflevector(vl0, vh0, 0, 1, 2, 3, 4, 5, 6, 7), pf, o0, 0, 0, 0); \
                    o1 = __builtin_amdgcn_mfma_f32_32x32x16_bf16(__builtin_shufflevector(vl1, vh1, 0, 1, 2, 3, 4, 5, 6, 7), pf, o1, 0, 0, 0); \
                } \
        } while (0)
        for (int kt2 = 0; kt2 < NKT; kt2 += 2) { { const int kt = kt2; ATT_ITER(kt, skA, srA, svA, pa0, pa1, pb0, pb1); } { const int kt = kt2 + 1; ATT_ITER(kt, skB, srB, svB, pb0, pb1, pa0, pa1); } }
#undef ATT_ITER
#undef KSRC
#undef RSRC
#undef VSRC
        const float ltot = lrun + __shfl_xor(lrun, 32), inv = 1.0f / ltot;
        bf16_t* op = O + tq * 1024 + h * 64;
#pragma unroll
        for (int dh = 0; dh < 2; ++dh)
#pragma unroll
            for (int g4 = 0; g4 < 4; ++g4) { const f32x16& oo = dh ? o1 : o0; u32x2 w;
                w.x = cvt_pk_bf16(oo[4 * g4] * inv, oo[4 * g4 + 1] * inv); w.y = cvt_pk_bf16(oo[4 * g4 + 2] * inv, oo[4 * g4 + 3] * inv);
                *(u32x2*)(op + dh * 32 + 8 * g4 + 4 * hi) = w; }
    }
    __syncthreads();
}

#define XB_TMO      128
#define XB_XCNT(j)  (256  + 64 * (j))
#define XB_XSUB(j)  (1280 + 64 * (j))
#define XB_XGEN(j)  (2304 + 64 * (j))
#define XB_TOP      3328
#define XB_TOPGEN   3392
#define XCD_BAR_WORDS 3456
#define XB_SPIN_CAP (1u << 18)
__device__ __forceinline__ unsigned xb_ld(unsigned* p)              { return __hip_atomic_load(p, __ATOMIC_RELAXED, __HIP_MEMORY_SCOPE_AGENT); }
__device__ __forceinline__ unsigned xb_add(unsigned* p, unsigned v) { return __hip_atomic_fetch_add(p, v, __ATOMIC_RELAXED, __HIP_MEMORY_SCOPE_AGENT); }
__device__ __forceinline__ unsigned xb_xcc_id() { return (unsigned)__builtin_amdgcn_s_getreg((3 << 11) | 20) & 0xFu; }
#define XB_SPIN(cond, bar) do { unsigned _sp = 0; while (cond) { __builtin_amdgcn_s_sleep(1); \
    if ((++_sp & 255u) == 0u) { if (xb_ld(&(bar)[XB_TMO])) break; if (_sp > XB_SPIN_CAP) { atomicAdd(&(bar)[XB_TMO], 1u); break; } } } } while (0)
struct XcdBarrier { unsigned* bar; unsigned x; volatile LAS unsigned* st; };
__device__ __forceinline__ XcdBarrier xcd_barrier_post(unsigned* bar, volatile LAS unsigned* st) {
    XcdBarrier b; b.bar = bar; b.x = xb_xcc_id(); b.st = st;
    if (threadIdx.x == 0) (void)xb_add(&bar[XB_XCNT(b.x)], 1u);
    return b;
}
__device__ __forceinline__ void xcd_barrier_complete(unsigned* bar, unsigned x, unsigned& nloc, unsigned& nx) {
    const unsigned G = gridDim.x * gridDim.y * gridDim.z;
    unsigned sum, cnt, mine, sp = 0u;
    for (;;) {
        sum = 0u; cnt = 0u; mine = 0u;
#pragma unroll
        for (unsigned j = 0; j < 16; ++j) { const unsigned c = xb_ld(&bar[XB_XCNT(j)]); sum += c; cnt += (c > 0u) ? 1u : 0u; mine = (j == x) ? c : mine; }
        if (sum == G) break;
        __builtin_amdgcn_s_sleep(1);
        if ((++sp & 255u) == 0u) { if (xb_ld(&bar[XB_TMO])) break; if (sp > XB_SPIN_CAP) { atomicAdd(&bar[XB_TMO], 1u); break; } }
    }
    nloc = mine > 0u ? mine : 1u; nx = cnt > 0u ? cnt : 1u;
}
__device__ __forceinline__ void xcd_barrier(const XcdBarrier& b) {
    asm volatile("s_waitcnt vmcnt(0)" ::: "memory");
    __syncthreads();
    if (threadIdx.x == 0) {
        unsigned* bar = b.bar;
        __builtin_amdgcn_s_waitcnt(0);
        unsigned nloc = b.st[0], nx = b.st[1];
        if (nloc == 0u) { xcd_barrier_complete(bar, b.x, nloc, nx); b.st[0] = nloc; b.st[1] = nx; }
        const unsigned old = xb_add(&bar[XB_XSUB(b.x)], 1u);
        const unsigned gen = old / nloc;
        if (old + 1u == (gen + 1u) * nloc) {
            __builtin_amdgcn_fence(__ATOMIC_RELEASE, "agent");
            asm volatile("s_waitcnt vmcnt(0)" ::: "memory");
            const unsigned og = xb_add(&bar[XB_TOP], 1u);
            const unsigned tg = og / nx;
            if (og + 1u == (tg + 1u) * nx) xb_add(&bar[XB_TOPGEN], 1u);
            else XB_SPIN(xb_ld(&bar[XB_TOPGEN]) == tg, bar);
            __builtin_amdgcn_fence(__ATOMIC_ACQUIRE, "agent");
            xb_add(&bar[XB_XGEN(b.x)], 1u);
            asm volatile("s_waitcnt vmcnt(0)" ::: "memory");
        } else {
            XB_SPIN(xb_ld(&bar[XB_XGEN(b.x)]) == gen, bar);
            __builtin_amdgcn_fence(__ATOMIC_ACQUIRE, "agent");
            asm volatile("s_waitcnt vmcnt(0)" ::: "memory");
        }
    }
    __syncthreads();
}

constexpr int NSTEPS = 20;
__device__ __forceinline__ int step_of(int it) { return it <= 2 ? it : (it == 3 ? 19 : it - 1); }
__device__ __forceinline__ bool step_needs_sync(int st) { return st != 11 && st != 12 && st != 19; }
__device__ __forceinline__ bool make_job(const Params& p, int st, GemmJob& j) {
    unsigned char* ws = p.ws; bf16_t* H = (bf16_t*)(ws + WS_H);
    j.bsA = 0; j.bsB = 0; j.bsO = 0; j.xp = p.in[0]; j.xs = p.in[1]; j.nB = 1; j.ldc = 1024; j.ssp = nullptr; j.xb = H; j.gather = 0; j.rs16 = 0; j.crot = 0; j.cw = nullptr; j.cb = nullptr; j.uh = nullptr;
    float* SSP = (float*)(ws + WS_SSP); float* RSTD = (float*)(ws + WS_RSTD);
    const int layer = st >= 15 ? 1 : 0;
    if (st == 1) { j.A = (const bf16_t*)(ws + WS_DFTC); j.B = (const bf16_t*)(ws + WS_HS); j.lda = 256; j.ldb = 1024; j.bsB = 256; j.K = 256; j.nM = 1; j.nN = NBATCH * 9; j.nB = 4; j.emode = EM_Y1T; j.O = ws + WS_Y1T; j.ldc = SEQH; return true; }
    if (st == 2) { j.A = (const bf16_t*)(ws + WS_A2); j.B = (const bf16_t*)(ws + WS_Y1T); j.lda = 1280; j.ldb = SEQH; j.bsB = (long)1024 * SEQH; j.K = 1280; j.nM = 4; j.nN = 4; j.nB = NBATCH; j.emode = EM_PLAIN; j.O = ws + WS_F; j.bsO = (long)2048 * 1024; j.ldc = 2048; return true; }
    if (st == 19) { j.A = (const bf16_t*)(ws + WS_A2) + (size_t)1024 * 1280; j.B = (const bf16_t*)(ws + WS_Y1T) + 1280; j.lda = 1024; j.ldb = SEQH; j.bsB = (long)1024 * SEQH; j.K = 1024; j.nM = 4; j.nN = 4; j.nB = NBATCH; j.emode = EM_PLAIN; j.O = (bf16_t*)(ws + WS_F) + 1024; j.bsO = (long)2048 * 1024; j.ldc = 2048; j.crot = 128; return true; }
    if (st == 3) { j.ssp = SSP; j.A = (const bf16_t*)(ws + WS_F); j.B = (const bf16_t*)(ws + WS_WFO); j.lda = 1024; j.ldb = 1024; j.K = 1024; j.nM = T / 256; j.nN = 4; j.emode = EM_RES0; j.O = p.out; return true; }
    if (st == 4 || st == 15) {
        j.A = H; j.B = (const bf16_t*)(ws + (layer ? WS_WUP1 : WS_WUP0)); j.lda = 1024; j.ldb = 1024; j.K = 1024; j.nM = 3; j.nN = FF2 / 256; j.emode = EM_PLAIN; j.O = ws + WS_UH; j.ldc = FF2; j.ssp = SSP; j.rs16 = 1; j.gather = 1; return true; }
    if (st == 5 || st == 16) {
        j.A = H; j.B = (const bf16_t*)(ws + (layer ? WS_WUP1 : WS_WUP0)); j.lda = 1024; j.ldb = 1024; j.K = 1024; j.nM = T / 256; j.nN = FF2 / 256; j.emode = EM_GATE; j.O = ws + WS_G; j.ldc = FF; j.ssp = RSTD;
        j.cw = p.in[12] + (size_t)layer * 3 * FF2; j.cb = p.in[13] + (size_t)layer * FF2; j.uh = (const bf16_t*)(ws + WS_UH); return true; }
    if (st == 6 || st == 17) { j.ssp = SSP; j.A = (const bf16_t*)(ws + WS_G); j.B = (const bf16_t*)(ws + (layer ? WS_WDN1 : WS_WDN0)); j.lda = FF; j.ldb = FF; j.K = FF; j.nM = T / 256; j.nN = 4; j.emode = EM_RES; j.O = p.out; return true; }
    if (st == 8) { j.A = H; j.B = (const bf16_t*)(ws + WS_WIN); j.lda = 1024; j.ldb = 1024; j.K = 1024; j.nM = T / 256; j.nN = 2; j.emode = EM_PLAIN; j.O = ws + WS_AA; j.ldc = 512; j.ssp = RSTD; return true; }
    if (st == 10) { j.A = (const bf16_t*)(ws + WS_CQ); j.B = (const bf16_t*)(ws + WS_WUQ); j.lda = 256; j.ldb = 256; j.K = 256; j.nM = T / 256; j.nN = 6; j.emode = EM_PLAIN; j.O = ws + WS_Q; j.ldc = 1536; return true; }
    if (st == 11) { j.A = (const bf16_t*)(ws + WS_CKV); j.B = (const bf16_t*)(ws + WS_WK); j.lda = 128; j.ldb = 128; j.K = 128; j.nM = T / 256; j.nN = 4; j.emode = EM_PLAIN; j.O = ws + WS_KN; return true; }
    if (st == 12) { j.A = (const bf16_t*)(ws + WS_WV); j.B = (const bf16_t*)(ws + WS_CKV); j.lda = 128; j.ldb = 128; j.K = 128; j.nM = 4; j.nN = T / 256; j.emode = EM_VT; j.O = ws + WS_VT; j.ldc = 2048; return true; }
    if (st == 14) { j.ssp = SSP; j.A = (const bf16_t*)(ws + WS_O); j.B = (const bf16_t*)(ws + WS_WO); j.lda = 1024; j.ldb = 1024; j.K = 1024; j.nM = T / 256; j.nN = 4; j.emode = EM_RES; j.O = p.out; return true; }
    return false;
}
__global__ void __launch_bounds__(NTHREADS, 2) mega(Params p) {
    extern __shared__ __attribute__((aligned(16))) unsigned char smem[];
    LAS unsigned char* lds = (LAS unsigned char*)smem;
    unsigned char* ws = p.ws;
    bf16_t* H = (bf16_t*)(ws + WS_H);
    XcdBarrier xbar; xbar.bar = (unsigned*)(ws + WS_BAR); xbar.x = 0; xbar.st = (volatile LAS unsigned*)(lds + LDS_XB);
    if (p.coop) {
        if (threadIdx.x < 4) ((LAS unsigned*)(lds + LDS_XB))[threadIdx.x] = 0u;
        __syncthreads();
        xbar = xcd_barrier_post((unsigned*)(ws + WS_BAR), (volatile LAS unsigned*)(lds + LDS_XB));
    }
    bool first_sync = true;
    for (int it = p.ph_lo; it < p.ph_hi; ++it) {
        const int st = step_of(it);
        if (it > p.ph_lo && p.coop && step_needs_sync(st)) {
            if (first_sync) { cg::this_grid().sync(); first_sync = false; }
            else xcd_barrier(xbar);
        }
        if (st == 4 || st == 7 || st == 15) {
            const float* SSP = (const float*)(ws + WS_SSP); float* RSTD = (float*)(ws + WS_RSTD);
            for (int row = obid() * NTHREADS + otid(); row < T; row += gridDim.x * NTHREADS) {
                const f32x4* q4 = (const f32x4*)(SSP + (size_t)row * 16); const f32x4 a = q4[0], b = q4[1], c = q4[2], d = q4[3];
                const float ss = ((a[0] + a[1]) + (a[2] + a[3])) + ((b[0] + b[1]) + (b[2] + b[3])) + ((c[0] + c[1]) + (c[2] + c[3])) + ((d[0] + d[1]) + (d[2] + d[3]));
                RSTD[row] = rsqrtf(ss * (1.0f / D) + EPS); }
        }
        GemmJob job;
        if (make_job(p, st, job)) { gemm_phase(lds, job); continue; }
        if (st == 0) {
            float* tile = (float*)smem;
            for (int w = 0; w < 10; ++w) {
                const float* src; const float* ksc = nullptr; float wsc = 1.0f; int K, N, ld, Np, cm = 0; size_t dsto;
                switch (w) {
                    case 0: src = p.in[3]; K = 1024; N = 1024; ld = 1024; Np = 1024; dsto = WS_WFO; break;
                    case 1: src = p.in[4]; K = 1024; N = 416; ld = 416; Np = 512; dsto = WS_WIN; ksc = p.in[2] + D; break;
                    case 2: src = p.in[7]; K = 256; N = 1536; ld = 1536; Np = 1536; dsto = WS_WUQ; wsc = 0.10206207261596577f * 1.4426950408889634f; break;
                    case 3: src = p.in[8]; K = 128; N = 1024; ld = 2048; Np = 1024; cm = 1; dsto = WS_WK; break;
                    case 4: src = p.in[8]; K = 128; N = 1024; ld = 2048; Np = 1024; cm = 2; dsto = WS_WV; break;
                    case 5: src = p.in[9]; K = 1024; N = 1024; ld = 1024; Np = 1024; dsto = WS_WO; break;
                    case 6: src = p.in[11]; K = 1024; N = FF2; ld = FF2; Np = FF2; dsto = WS_WUP0; ksc = p.in[10]; cm = 3; break;
                    case 7: src = p.in[11] + (size_t)1024 * FF2; K = 1024; N = FF2; ld = FF2; Np = FF2; dsto = WS_WUP1; ksc = p.in[10] + D; cm = 3; break;
                    case 8: src = p.in[14]; K = FF; N = 1024; ld = 1024; Np = 1024; dsto = WS_WDN0; break;
                    default: src = p.in[14] + (size_t)FF * 1024; K = FF; N = 1024; ld = 1024; Np = 1024; dsto = WS_WDN1; break;
                }
                transpose_w(src, K, N, ld, (bf16_t*)(ws + dsto), Np, cm, ksc, wsc, tile);
            }
            gen_tables(p);
        }
        if (st == 0 || st == 18) { rmsnorm_pass(p, st == 0 ? 0 : 2, st == 0 ? p.in[2] : p.in[15], H); continue; }
        if (st == 9) { mla_mid_pass(p); continue; }
        if (st == 13) { attn_phase(p, lds); continue; }
    }
}

#ifndef N_LAUNCH_MODE
#define N_LAUNCH_MODE 1
#endif
extern "C" void kernel_launch(void* const* d_in, const int* in_sizes, int n_in, void* d_out, int out_size, void* d_ws, size_t ws_size, hipStream_t stream) {
    static int grid = 0;
    if (grid == 0) {
        if (n_in != 16 || out_size != T * D || ws_size < WS_END) { fprintf(stderr, "kernel_launch: unexpected shapes n_in %d out %d ws %zu (need %zu)\n", n_in, out_size, ws_size, (size_t)WS_END); grid = -1; return; }
        int dev = 0, cus = 0, per_cu = 0;
        hipGetDevice(&dev); hipDeviceGetAttribute(&cus, hipDeviceAttributeMultiprocessorCount, dev);
        if (hipFuncSetAttribute((const void*)mega, hipFuncAttributeMaxDynamicSharedMemorySize, LDS_BYTES) != hipSuccess) { fprintf(stderr, "kernel_launch: hipFuncSetAttribute failed\n"); grid = -1; return; }
        if (hipOccupancyMaxActiveBlocksPerMultiprocessor(&per_cu, (const void*)mega, NTHREADS, LDS_BYTES) != hipSuccess || per_cu < 1) { fprintf(stderr, "kernel_launch: occupancy query says %d\n", per_cu); per_cu = 1; }
        (void)hipGetLastError();
        grid = cus * 1;
    }
    if (grid < 0) return;
    Params p{};
    for (int i = 0; i < 16; ++i) p.in[i] = (const float*)d_in[i];
    p.out = (float*)d_out; p.ws = (unsigned char*)d_ws;
#if N_LAUNCH_MODE == 1
    if (hipMemsetAsync((char*)d_ws + WS_BAR, 0, XCD_BAR_WORDS * 4, stream) != hipSuccess) { fprintf(stderr, "kernel_launch: memset of barrier words failed\n"); return; }
    p.ph_lo = 0; p.ph_hi = NSTEPS; p.coop = 1;
    void* args[] = {&p};
    hipError_t e = hipLaunchCooperativeKernel((const void*)mega, dim3(grid), dim3(NTHREADS), args, LDS_BYTES, stream);
    if (e != hipSuccess) fprintf(stderr, "cooperative launch failed: %s (grid %d)\n", hipGetErrorString(e), grid);
#else
    for (int ph = 0; ph < NSTEPS; ++ph) {
        p.ph_lo = ph; p.ph_hi = ph + 1; p.coop = 0;
        hipLaunchKernelGGL(mega, dim3(grid), dim3(NTHREADS), LDS_BYTES, stream, p);
    }
#endif
}
```

```cpp
#include <hip/hip_runtime.h>
#include <hip/hip_cooperative_groups.h>
#include <cstdio>
#include <cstdint>
namespace cg = cooperative_groups;

#define LAS __attribute__((address_space(3)))
typedef unsigned short bf16_t;
typedef short bf16x8 __attribute__((ext_vector_type(8)));
typedef short s16x4 __attribute__((ext_vector_type(4)));
typedef float f32x4 __attribute__((ext_vector_type(4)));
typedef float f32x2 __attribute__((ext_vector_type(2)));
typedef float f32x16 __attribute__((ext_vector_type(16)));
typedef unsigned u32x4 __attribute__((ext_vector_type(4)));
typedef unsigned u32x2 __attribute__((ext_vector_type(2)));

constexpr int T = 81920, D = 1024, SEQ = 2048, NBATCH = 40, TP = 65536;
constexpr int FF = 2816, FF2 = 5632;
constexpr int NH = 16;
constexpr float EPS = 1e-6f;
constexpr size_t MiB = 1024ull * 1024ull;
constexpr size_t WS_WFO = 0, WS_WIN = 2 * MiB, WS_WUQ = 3 * MiB, WS_WK = 4 * MiB, WS_WV = 4 * MiB + 512 * 1024, WS_WO = 5 * MiB,
                 WS_WUP0 = 7 * MiB, WS_WUP1 = 18 * MiB, WS_WDN0 = 29 * MiB, WS_WDN1 = 35 * MiB, WS_DFTC = 41 * MiB, WS_ROPE = 42 * MiB,
                 WS_A2 = 43 * MiB, WS_SSP = 59 * MiB, WS_H = 64 * MiB, WS_BIG = 224 * MiB;
constexpr size_t WS_BAR = WS_ROPE + 896 * 1024;
constexpr size_t WS_RSTD = WS_ROPE + 512 * 1024;
constexpr size_t WS_Y1T = WS_BIG, WS_F = WS_BIG + 320 * MiB, WS_HS = WS_BIG + 480 * MiB;
constexpr int SEQH = 2304;
constexpr size_t WS_G = WS_BIG, WS_UH = WS_BIG + 440 * MiB;
constexpr size_t WS_Q = WS_BIG, WS_AA = WS_BIG, WS_KN = WS_BIG + 240 * MiB, WS_VT = WS_BIG + 400 * MiB, WS_CQ = WS_BIG + 560 * MiB, WS_CKV = WS_BIG + 600 * MiB,
                 WS_KR = WS_BIG + 620 * MiB, WS_O = WS_BIG + 625 * MiB;
constexpr size_t WS_END = WS_BIG + 785 * MiB;
constexpr int LDS_XB = 131072 + 16384;
constexpr int LDS_SIDE = 131072 + 16384 + 32;
constexpr int LDS_BYTES = LDS_SIDE + 2 * 6144;
constexpr int NTHREADS = 512;

struct Params {
    const float* in[16];
    float* out;
    unsigned char* ws;
    int ph_lo, ph_hi, coop, pad;
};

__device__ __forceinline__ int otid() { int t = threadIdx.x; asm volatile("" : "+v"(t)); return t; }
__device__ __forceinline__ int obid() { int b = blockIdx.x; asm volatile("" : "+s"(b)); return b; }
__device__ __forceinline__ unsigned cvt_pk_bf16(float lo, float hi) { unsigned r; asm volatile("v_cvt_pk_bf16_f32 %0, %1, %2" : "=v"(r) : "v"(lo), "v"(hi)); return r; }
__device__ __forceinline__ float bf2f(unsigned short b) { return __uint_as_float(((unsigned)b) << 16); }
__device__ __forceinline__ float bflo(unsigned w) { return __uint_as_float(w << 16); }
__device__ __forceinline__ float bfhi(unsigned w) { return __uint_as_float(w & 0xffff0000u); }
__device__ __forceinline__ const float* xrow0(const Params& p, int row) { return row < TP ? p.in[0] + (size_t)row * D : p.in[1] + (size_t)(row - TP) * D; }

constexpr int BM = 256, BK = 64, HALF = 128, HTB = HALF * BK * 2, NXCD = 8, WGM = 8;
__device__ __forceinline__ int lds_byte(int r, int c) { const int st = (r >> 4) * 2 + (c >> 5), rr = r & 15, cc = c & 31, ob = rr * 64 + cc * 2; return st * 1024 + (ob ^ (((ob >> 9) & 1) << 5)); }
__device__ __forceinline__ void stage_rc(int b, int& R, int& C) { const int st = b / 1024, sb = b % 1024, swz = sb ^ (((sb >> 9) & 1) << 5); R = (st >> 1) * 16 + swz / 64; C = (st & 1) * 32 + (swz % 64) / 2; }
__device__ __forceinline__ int perm32(int rho) { const int n = rho >> 4, i = rho & 15; return 8 * (i >> 2) + 4 * n + (i & 3); }

struct Unit { int pm, pn, bz; };
__device__ __forceinline__ bool y1t_sin(int vt) { return vt == 3 || vt == 4 || vt >= 7; }
enum { EM_PLAIN = 0, EM_Y1T = 1, EM_VT = 2, EM_GATE = 3, EM_RES0 = 4, EM_RES = 5 };
struct GemmJob { const bf16_t* A; const bf16_t* B; long bsA, bsB, bsO; void* O; const float* xp; const float* xs; float* ssp; bf16_t* xb; const float* cw; const float* cb; const bf16_t* uh; int lda, ldb, K, nM, nN, nB, emode, ldc, gather, rs16; };

struct Sched {
    int nM, nN, nB, nwg, G, c;
    __device__ __forceinline__ void init(int nM_, int nN_, int nB_, int G_, int c_) { nM = nM_; nN = nN_; nB = nB_; nwg = nM * nN * nB; G = G_; c = c_; }
    __device__ __forceinline__ bool next(int i, Unit& u) const {
        const long L = (long)i * G + c; if (L >= nwg) return false;
        int wgid = (int)L; { const int q = nwg / NXCD, r = nwg % NXCD, xcd = wgid % NXCD, off = wgid / NXCD; wgid = (xcd < r ? xcd * (q + 1) : r * (q + 1) + (xcd - r) * q) + off; }
        const int nMf = nM * nB, nig = WGM * nN, gid = wgid / nig, fm = gid * WGM, gsz = (nMf - fm) < WGM ? (nMf - fm) : WGM;
        const int pmf = fm + ((wgid % nig) % gsz); u.pn = (wgid % nig) / gsz; u.bz = pmf / nM; u.pm = pmf % nM; return true;
    }
};

__device__ __forceinline__ float dpp_ror1(float src) { return __int_as_float(__builtin_amdgcn_update_dpp(0, __float_as_int(src), 0x121, 0xf, 0xf, true)); }
__device__ __forceinline__ float dpp_ror15(float src) { return __int_as_float(__builtin_amdgcn_update_dpp(0, __float_as_int(src), 0x12f, 0xf, 0xf, true)); }
__device__ __forceinline__ float dpp_up(float old, float src) { return __int_as_float(__builtin_amdgcn_update_dpp(__float_as_int(old), __float_as_int(src), 0x111, 0xf, 0xf, false)); }
__device__ __forceinline__ float dpp_dn(float old, float src) { return __int_as_float(__builtin_amdgcn_update_dpp(__float_as_int(old), __float_as_int(src), 0x101, 0xf, 0xf, false)); }
__device__ __forceinline__ void epilogue(const GemmJob& g, f32x4 (&acc)[2][2][4][2], const Unit& u, int wr, int wc, int fr_, int fq_, LAS unsigned char* lds, int par) {
    int fr = fr_, fq = fq_; asm volatile("" : "+v"(fr), "+v"(fq));
    if (g.emode == EM_GATE) {
        LAS unsigned char* E = lds + 131072;
        const LAS unsigned char* SD = lds + LDS_SIDE + par * 6144;
        float rsv[2][4];
#pragma unroll
        for (int ai = 0; ai < 2; ++ai)
#pragma unroll
            for (int m = 0; m < 4; ++m) rsv[ai][m] = *(const LAS float*)(SD + (ai * HALF + wr * 64 + m * 16 + fr) * 4);
        const int cl = wc * 32 + 8 * fq;
        const bool e0 = (fr == 0), e15 = (fr == 15);
#pragma unroll
        for (int ai = 0; ai < 2; ++ai)
#pragma unroll
            for (int m = 0; m < 4; ++m) {
                const float rstd = rsv[ai][m];
#pragma unroll
                for (int bj = 0; bj < 2; ++bj)
#pragma unroll
                    for (int n = 0; n < 2; ++n) acc[ai][bj][m][n] = acc[ai][bj][m][n] * rstd;
                if (e0 || e15) { const int er = 2 * (8 * ai + 4 * wr + m) + (e15 ? 1 : 0);
#pragma unroll
                    for (int bj = 0; bj < 2; ++bj) { const f32x4 v0 = acc[ai][bj][m][0], v1 = acc[ai][bj][m][1];
                        u32x4 w; w.x = cvt_pk_bf16(v0[0], v0[1]); w.y = cvt_pk_bf16(v0[2], v0[3]); w.z = cvt_pk_bf16(v1[0], v1[1]); w.w = cvt_pk_bf16(v1[2], v1[3]);
                        *(LAS u32x4*)(E + (er * 256 + bj * HALF + cl) * 2) = w; } }
            }
        asm volatile("s_waitcnt lgkmcnt(0)" ::: "memory"); __builtin_amdgcn_s_barrier(); asm volatile("" ::: "memory");
        const int pmq = u.pm & 7;
        u32x2 keep[2][4];
#pragma unroll
        for (int n = 0; n < 2; ++n) {
            const int f0 = u.pn * 128 + cl;
            f32x4 wg[3], wv[3];
#pragma unroll
            for (int k = 0; k < 3; ++k) { wg[k] = *(const LAS f32x4*)(SD + 1024 + k * 1024 + (cl + 4 * n) * 4); wv[k] = *(const LAS f32x4*)(SD + 1024 + k * 1024 + 512 + (cl + 4 * n) * 4); }
            const f32x4 bg = *(const LAS f32x4*)(SD + 4096 + (cl + 4 * n) * 4), bv = *(const LAS f32x4*)(SD + 4096 + 512 + (cl + 4 * n) * 4);
            bf16_t* gout = (bf16_t*)g.O + (size_t)(u.pm * BM + wr * 64 + fr) * FF + f0;
#pragma unroll
            for (int ai = 0; ai < 2; ++ai)
#pragma unroll
                for (int m = 0; m < 4; ++m) {
                    const int gi = 8 * ai + 4 * wr + m;
                    u32x2 wu[2], wd[2];
                    if (ai == 0 && m == 0 && wr == 0) {
#pragma unroll
                        for (int bj = 0; bj < 2; ++bj) { wu[bj] = (u32x2){0u, 0u}; if (pmq != 0) wu[bj] = *(const LAS u32x2*)(SD + 5120 + (bj * HALF + cl + 4 * n) * 2); }
                    } else {
#pragma unroll
                        for (int bj = 0; bj < 2; ++bj) wu[bj] = *(const LAS u32x2*)(E + ((2 * gi - 1) * 256 + bj * HALF + cl + 4 * n) * 2);
                    }
                    if (ai == 1 && m == 3 && wr == 1) {
#pragma unroll
                        for (int bj = 0; bj < 2; ++bj) { wd[bj] = (u32x2){0u, 0u}; if (pmq != 7) wd[bj] = *(const LAS u32x2*)(SD + 5632 + (bj * HALF + cl + 4 * n) * 2); }
                    } else {
#pragma unroll
                        for (int bj = 0; bj < 2; ++bj) wd[bj] = *(const LAS u32x2*)(E + ((2 * gi + 2) * 256 + bj * HALF + cl + 4 * n) * 2);
                    }
                    float o[4];
#pragma unroll
                    for (int j = 0; j < 4; ++j) {
                        const float cg_ = acc[ai][0][m][n][j], cv_ = acc[ai][1][m][n][j];
                        const unsigned pug = (j < 2) ? wu[0].x : wu[0].y, pdg = (j < 2) ? wd[0].x : wd[0].y, puv = (j < 2) ? wu[1].x : wu[1].y, pdv = (j < 2) ? wd[1].x : wd[1].y;
                        const float eug = (j & 1) ? bfhi(pug) : bflo(pug), edg = (j & 1) ? bfhi(pdg) : bflo(pdg), euv = (j & 1) ? bfhi(puv) : bflo(puv), edv = (j & 1) ? bfhi(pdv) : bflo(pdv);
                        const float ug = dpp_up(eug, cg_), dg = dpp_dn(edg, cg_);
                        const float uv = dpp_up(euv, cv_), dv = dpp_dn(edv, cv_);
                        const float gt = wg[0][j] * ug + wg[1][j] * cg_ + wg[2][j] * dg + bg[j];
                        const float vl = wv[0][j] * uv + wv[1][j] * cv_ + wv[2][j] * dv + bv[j];
                        o[j] = gt * __builtin_amdgcn_rcpf(1.0f + __builtin_amdgcn_exp2f(-1.4426950408889634f * gt)) * vl;
                    }
                    u32x2 ow; ow.x = cvt_pk_bf16(o[0], o[1]); ow.y = cvt_pk_bf16(o[2], o[3]);
                    if (n == 0) keep[ai][m] = ow;
                    else { u32x4 o4; o4.x = keep[ai][m].x; o4.y = keep[ai][m].y; o4.z = ow.x; o4.w = ow.y; *(u32x4*)(gout + (size_t)(ai * HALF + m * 16) * FF) = o4; }
                }
            asm volatile("" ::: "memory");
        }
        return;
    }
    if (g.emode <= EM_VT) {
        bf16_t* O = (bf16_t*)g.O; bf16_t* base;
        if (g.emode == EM_PLAIN) base = O + (size_t)u.bz * g.bsO + (size_t)u.pm * BM * g.ldc + (size_t)u.pn * BM;
        else if (g.emode == EM_Y1T) base = O + ((size_t)(u.pn / 9) * 1024 + (size_t)u.bz * 256) * SEQH + (size_t)(u.pn % 9) * 256;
        else base = O + ((size_t)(u.pn >> 3) * 1024 + (size_t)u.pm * 256) * 2048 + (size_t)(u.pn & 7) * 256;
        unsigned off = (unsigned)((wr * 64 + fr) * g.ldc + wc * 32 + 8 * fq) * 2u;
        const unsigned rstep = (unsigned)(16 * g.ldc) * 2u;
        float rsv[2][4];
#pragma unroll
        for (int ai = 0; ai < 2; ++ai)
#pragma unroll
            for (int m = 0; m < 4; ++m) rsv[ai][m] = 1.0f;
        if (g.ssp != nullptr) {
            if (g.rs16) {
#pragma unroll
                for (int ai = 0; ai < 2; ++ai)
#pragma unroll
                    for (int m = 0; m < 4; ++m) { const int i = u.pm * BM + ai * HALF + wr * 64 + m * 16 + fr, grow = 256 * (i >> 1) + 255 + (i & 1);
                        const f32x4* q4 = (const f32x4*)(g.ssp + (size_t)(grow < T ? grow : T - 1) * 16); const f32x4 a = q4[0], b = q4[1], c = q4[2], d = q4[3];
                        const float ss = ((a[0] + a[1]) + (a[2] + a[3])) + ((b[0] + b[1]) + (b[2] + b[3])) + ((c[0] + c[1]) + (c[2] + c[3])) + ((d[0] + d[1]) + (d[2] + d[3]));
                        rsv[ai][m] = rsqrtf(ss * (1.0f / D) + EPS); }
            } else { const float* sp = g.ssp + (u.pm * BM + wr * 64 + fr);
#pragma unroll
                for (int ai = 0; ai < 2; ++ai)
#pragma unroll
                    for (int m = 0; m < 4; ++m) rsv[ai][m] = sp[ai * HALF + m * 16]; } }
#pragma unroll
        for (int ai = 0; ai < 2; ++ai) {
#pragma unroll
            for (int m = 0; m < 4; ++m) {
                const float rstd = rsv[ai][m];
#pragma unroll
                for (int bj = 0; bj < 2; ++bj) { const f32x4 v0 = acc[ai][bj][m][0] * rstd, v1 = acc[ai][bj][m][1] * rstd;
                    u32x4 w; w.x = cvt_pk_bf16(v0[0], v0[1]); w.y = cvt_pk_bf16(v0[2], v0[3]); w.z = cvt_pk_bf16(v1[0], v1[1]); w.w = cvt_pk_bf16(v1[2], v1[3]);
                    *(u32x4*)((char*)base + off + bj * HALF * 2) = w; }
                off += rstep; }
            off += rstep * 4; }
    } else {
        const int row0 = u.pm * BM;
        bf16_t* xbase = g.xb + (size_t)row0 * D;
        const float* rbase = (row0 < TP ? g.xp + (size_t)row0 * D : g.xs + (size_t)(row0 - TP) * D);
        const unsigned off0 = (unsigned)((wr * 64 + fr) * D + u.pn * BM + wc * 32 + 8 * fq) * 2u;
        float* sp = g.ssp + (size_t)(row0 + wr * 64 + fr) * 16 + u.pn * 4 + wc;
#define RES_OFF(gi_) (off0 + (unsigned)(((gi_) >> 2) * HALF + ((gi_) & 3) * 16) * (unsigned)(D * 2))
#define RES_FIN(gi_, bj_, x0_, x1_) do { u32x4 w; w.x = cvt_pk_bf16(x0_[0], x0_[1]); w.y = cvt_pk_bf16(x0_[2], x0_[3]); w.z = cvt_pk_bf16(x1_[0], x1_[1]); w.w = cvt_pk_bf16(x1_[2], x1_[3]); \
            *(u32x4*)((char*)xbase + RES_OFF(gi_) + (bj_) * HALF * 2) = w; \
            _Pragma("unroll") for (int e_ = 0; e_ < 4; ++e_) { const float ya = bflo(w[e_]), yb = bfhi(w[e_]); ss += ya * ya + yb * yb; } } while (0)
        if (g.emode == EM_RES0) {
#pragma unroll
            for (int gp = 0; gp < 4; ++gp) {
                f32x4 rr[2][2][2];
#pragma unroll
                for (int h2 = 0; h2 < 2; ++h2)
#pragma unroll
                    for (int bj = 0; bj < 2; ++bj)
#pragma unroll
                        for (int n = 0; n < 2; ++n) rr[h2][bj][n] = *(const f32x4*)((const char*)rbase + 2 * (RES_OFF(2 * gp + h2) + bj * HALF * 2) + n * 16);
#pragma unroll
                for (int h2 = 0; h2 < 2; ++h2) {
                    const int gi = 2 * gp + h2, ai = gi >> 2, m = gi & 3;
                    float ss = 0.f;
#pragma unroll
                    for (int bj = 0; bj < 2; ++bj) { const f32x4 x0 = rr[h2][bj][0] + acc[ai][bj][m][0], x1 = rr[h2][bj][1] + acc[ai][bj][m][1]; RES_FIN(gi, bj, x0, x1); }
                    ss += __shfl_xor(ss, 16); ss += __shfl_xor(ss, 32);
                    if (fq == 0) sp[(size_t)(ai * HALF + m * 16) * 16] = ss;
                }
            }
        } else {
            u32x4 ra[4][2], rb[4][2];
#define RES_LOAD(dst, g0_) _Pragma("unroll") for (int m_ = 0; m_ < 4; ++m_) _Pragma("unroll") for (int bj = 0; bj < 2; ++bj) dst[m_][bj] = *(const u32x4*)((const char*)xbase + RES_OFF((g0_) + m_) + bj * HALF * 2)
#define RES_PROC(src, gi_) do { const int gi = (gi_), ai = gi >> 2, m = gi & 3; float ss = 0.f; \
                _Pragma("unroll") for (int bj = 0; bj < 2; ++bj) { const u32x4 rw = src[m][bj]; \
                    const f32x4 x0 = (f32x4){bflo(rw.x), bfhi(rw.x), bflo(rw.y), bfhi(rw.y)} + acc[ai][bj][m][0], x1 = (f32x4){bflo(rw.z), bfhi(rw.z), bflo(rw.w), bfhi(rw.w)} + acc[ai][bj][m][1]; \
                    RES_FIN(gi, bj, x0, x1); } \
                ss += __shfl_xor(ss, 16); ss += __shfl_xor(ss, 32); \
                if (fq == 0) sp[(size_t)(ai * HALF + m * 16) * 16] = ss; } while (0)
            RES_LOAD(ra, 0);
            RES_PROC(ra, 0); RES_PROC(ra, 1);
            RES_LOAD(rb, 4);
            RES_PROC(ra, 2); RES_PROC(ra, 3);
            RES_PROC(rb, 4); RES_PROC(rb, 5); RES_PROC(rb, 6); RES_PROC(rb, 7);
#undef RES_LOAD
#undef RES_PROC
        }
#undef RES_FIN
#undef RES_OFF
    }
}

__device__ __forceinline__ void gemm_phase(LAS unsigned char* lds, const GemmJob& g) {
    Sched S; S.init(g.nM, g.nN, g.nB, (int)gridDim.x, obid());
    int tid = threadIdx.x; asm volatile("" : "+v"(tid));
    const int wid = __builtin_amdgcn_readfirstlane(tid >> 6), lane = tid & 63, wr = wid >> 2, wc = wid & 3, fr = lane & 15, fq = lane >> 4;
    const int K = g.K, nt = K / BK;
    unsigned voffA[2], voffB[2];
#pragma unroll
    for (int i = 0; i < 2; ++i) { int R, C; stage_rc(tid * 16 + i * 8192, R, C); const int Rb = (R & ~31) + perm32(R & 31);
        const int Ra = g.gather ? ((R >> 1) * 256 + 255 + (R & 1)) : R;
        voffA[i] = (unsigned)(Ra * g.lda + C) * 2u; voffB[i] = (unsigned)(Rb * g.ldb + C) * 2u; }
    const size_t kstep = (size_t)(BK * 2);
    const size_t hstepA = (size_t)(g.gather ? 64 * 256 : HALF) * g.lda * 2, hstepB = (size_t)HALF * g.ldb * 2;
    const size_t tstepA = (size_t)(g.gather ? 128 * 256 : BM) * g.lda * 2;
    const unsigned ldsw = (unsigned)wid * 1024u;
    const int aoff = lds_byte(wr * 64 + fr, fq * 8), boff = lds_byte(wc * 32 + fr, fq * 8);
#define PG8_SA(b, h) (((b) * 2 + (h)) * HTB)
#define PG8_SB(b, h) ((4 + (b) * 2 + (h)) * HTB)
#define PG8_STAGE(bufoff, gbase, voff) do { _Pragma("unroll") for (int _i = 0; _i < 2; ++_i) \
        __builtin_amdgcn_global_load_lds((const unsigned*)((const char*)(gbase) + (voff)[_i]), (LAS unsigned*)(lds + (bufoff) + ldsw + _i * 8192), 16, 0, 0); } while (0)
#define PG8_LDA(dst, b, h) do { _Pragma("unroll") for (int m = 0; m < 4; ++m) _Pragma("unroll") for (int k = 0; k < 2; ++k) dst[m][k] = *(const LAS bf16x8*)(lds + PG8_SA(b, h) + aoff + m * 2048 + k * 1024); } while (0)
#define PG8_LDB(dst, b, h) do { _Pragma("unroll") for (int n = 0; n < 2; ++n) _Pragma("unroll") for (int k = 0; k < 2; ++k) dst[n][k] = *(const LAS bf16x8*)(lds + PG8_SB(b, h) + boff + n * 2048 + k * 1024); } while (0)
#define PG8_MMA(ai, bj, At, Bt) do { __builtin_amdgcn_s_setprio(1); _Pragma("unroll") for (int m = 0; m < 4; ++m) _Pragma("unroll") for (int n = 0; n < 2; ++n) _Pragma("unroll") for (int k = 0; k < 2; ++k) \
        acc[ai][bj][m][n] = __builtin_amdgcn_mfma_f32_16x16x32_bf16(Bt[n][k], At[m][k], acc[ai][bj][m][n], 0, 0, 0); __builtin_amdgcn_s_setprio(0); } while (0)
#define PG8_WAIT_V(n) asm volatile("s_waitcnt vmcnt(" #n ")" ::: "memory")
#define PG8_WAIT_L(n) asm volatile("s_waitcnt lgkmcnt(" #n ")" ::: "memory")
#define PG8_BAR __builtin_amdgcn_s_barrier()
#define PG8_SCHED __builtin_amdgcn_sched_barrier(0)
#define PG8_SIDE(U, PAR) do { if (g.emode == EM_GATE && wid < 6) { const int half_ = lane >> 5, l32_ = lane & 31; const char* gp_; \
        if (wid == 0) gp_ = (const char*)(g.ssp + (U).pm * BM) + lane * 16; \
        else if (wid <= 3) gp_ = (const char*)(g.cw + (size_t)(wid - 1) * FF2 + half_ * FF + (U).pn * 128) + l32_ * 16; \
        else if (wid == 4) gp_ = (const char*)(g.cb + half_ * FF + (U).pn * 128) + l32_ * 16; \
        else { const int hr_ = half_ ? 2 * (U).pm + 1 : ((U).pm > 0 ? 2 * ((U).pm - 1) : 0); gp_ = (const char*)(g.uh + (size_t)hr_ * FF2 + (U).pn * BM) + l32_ * 16; } \
        __builtin_amdgcn_global_load_lds((const unsigned*)gp_, (LAS unsigned*)(lds + LDS_SIDE + (PAR) * 6144 + wid * 1024), 16, 0, 0); } } while (0)
    Unit cur, nxt; int ui = 0;
    if (!S.next(0, cur)) return;
    PG8_SIDE(cur, 0);
    f32x4 acc[2][2][4][2];
#pragma unroll
    for (int a = 0; a < 2; ++a)
#pragma unroll
        for (int b = 0; b < 2; ++b)
#pragma unroll
            for (int m = 0; m < 4; ++m)
#pragma unroll
                for (int n = 0; n < 2; ++n) acc[a][b][m][n] = (f32x4){0.f, 0.f, 0.f, 0.f};
    bf16x8 At[4][2], B0[2][2], B1[2][2];
    const char* cA = (const char*)g.A + (size_t)cur.bz * g.bsA * 2 + (size_t)cur.pm * tstepA + ((g.emode == EM_Y1T && y1t_sin(cur.pn % 9)) ? (size_t)256 * 256 * 2 : (size_t)0);
    const char* cB = (const char*)g.B + ((size_t)cur.bz * g.bsB + (size_t)cur.pn * BM * g.ldb) * 2;
    PG8_STAGE(PG8_SB(0, 0), cB, voffB); PG8_STAGE(PG8_SB(0, 1), cB + hstepB, voffB); PG8_STAGE(PG8_SA(0, 0), cA, voffA); PG8_STAGE(PG8_SA(0, 1), cA + hstepA, voffA);
    if (wr == 1) PG8_BAR;
    PG8_WAIT_V(2); PG8_BAR;
    PG8_STAGE(PG8_SB(1, 0), cB + kstep, voffB); PG8_STAGE(PG8_SA(1, 0), cA + kstep, voffA); PG8_STAGE(PG8_SB(1, 1), cB + hstepB + kstep, voffB);
    PG8_WAIT_V(6); PG8_BAR;
    for (;;) {
        const bool has_next = S.next(ui + 1, nxt);
        const char* nA = has_next ? (const char*)g.A + (size_t)nxt.bz * g.bsA * 2 + (size_t)nxt.pm * tstepA + ((g.emode == EM_Y1T && y1t_sin(nxt.pn % 9)) ? (size_t)256 * 256 * 2 : (size_t)0) : cA;
        const char* nB = has_next ? (const char*)g.B + ((size_t)nxt.bz * g.bsB + (size_t)nxt.pn * BM * g.ldb) * 2 : cB;
        for (int t = 0; t < nt; t += 2) {
            const bool last = (t == nt - 2);
            const char* a1 = cA + (size_t)(t + 1) * kstep;
            const char* a2 = last ? nA : cA + (size_t)(t + 2) * kstep; const char* b2 = last ? nB : cB + (size_t)(t + 2) * kstep;
            const char* a3 = a2 + kstep; const char* b3 = b2 + kstep;
            PG8_LDB(B0, 0, 0); PG8_LDB(B1, 0, 1); PG8_SCHED; PG8_LDA(At, 0, 0); PG8_STAGE(PG8_SA(1, 1), a1 + hstepA, voffA);
            PG8_WAIT_V(8); PG8_WAIT_L(0); PG8_BAR; PG8_MMA(0, 0, At, B0); PG8_MMA(0, 1, At, B1); PG8_BAR; PG8_SCHED;
            PG8_LDA(At, 0, 1); PG8_STAGE(PG8_SB(0, 0), b2, voffB); PG8_STAGE(PG8_SB(0, 1), b2 + hstepB, voffB); PG8_STAGE(PG8_SA(0, 0), a2, voffA);
            PG8_WAIT_V(8); PG8_WAIT_L(0); PG8_BAR; PG8_MMA(1, 0, At, B0); PG8_MMA(1, 1, At, B1); PG8_BAR; PG8_SCHED;
            PG8_LDB(B0, 1, 0); PG8_LDB(B1, 1, 1); PG8_SCHED; PG8_LDA(At, 1, 0); PG8_STAGE(PG8_SA(0, 1), a2 + hstepA, voffA);
            PG8_WAIT_V(8); PG8_WAIT_L(0); PG8_BAR; PG8_MMA(0, 0, At, B0); PG8_MMA(0, 1, At, B1); PG8_BAR; PG8_SCHED;
            PG8_LDA(At, 1, 1); PG8_STAGE(PG8_SB(1, 0), b3, voffB); PG8_STAGE(PG8_SB(1, 1), b3 + hstepB, voffB); PG8_STAGE(PG8_SA(1, 0), a3, voffA);
            PG8_WAIT_V(8); PG8_WAIT_L(0); PG8_BAR; PG8_MMA(1, 0, At, B0); PG8_MMA(1, 1, At, B1); PG8_BAR; PG8_SCHED;
        }
        if (wr == 0) PG8_BAR;
        epilogue(g, acc, cur, wr, wc, fr, fq, lds, ui & 1);
        if (!has_next) break;
        PG8_SIDE(nxt, (ui + 1) & 1);
#pragma unroll
        for (int a = 0; a < 2; ++a)
#pragma unroll
            for (int b = 0; b < 2; ++b)
#pragma unroll
                for (int m = 0; m < 4; ++m)
#pragma unroll
                    for (int n = 0; n < 2; ++n) acc[a][b][m][n] = (f32x4){0.f, 0.f, 0.f, 0.f};
        cur = nxt; cA = nA; cB = nB; ++ui;
        if (wr == 1) PG8_BAR;
    }
    PG8_WAIT_V(0);
    PG8_BAR;
#undef PG8_SIDE
#undef PG8_SA
#undef PG8_SB
#undef PG8_STAGE
#undef PG8_LDA
#undef PG8_LDB
#undef PG8_MMA
#undef PG8_WAIT_V
#undef PG8_WAIT_L
#undef PG8_BAR
#undef PG8_SCHED
}

__device__ void transpose_w(const float* src, int K, int N, int ldsrc, bf16_t* dst, int Npad, int cmode, const float* kscale, float wscale, float* tile) {
    const int tidx_ = otid(), bidx_ = obid(); (void)tidx_; (void)bidx_;
    const int tid = tidx_, ntk = K / 64, ntn = Npad / 64;
    for (int t = bidx_; t < ntk * ntn; t += gridDim.x) {
        const int k0 = (t % ntk) * 64, n0 = (t / ntk) * 64;
#pragma unroll
        for (int i = 0; i < 2; ++i) { const int kk = (tid >> 4) + 32 * i, nn = (tid & 15) * 4;
            f32x4 v = (f32x4){0.f, 0.f, 0.f, 0.f};
            const int blk = n0 / 64, c0 = cmode == 0 ? n0 : cmode == 1 ? blk * 128 : cmode == 2 ? blk * 128 + 64 : ((blk >> 1) & 1) * FF + (blk >> 2) * 128 + (blk & 1) * 64;
            if (n0 + nn < N) v = *(const f32x4*)(src + (size_t)(k0 + kk) * ldsrc + c0 + nn);
            v = v * (kscale ? kscale[k0 + kk] * wscale : wscale);
            tile[kk * 65 + nn] = v[0]; tile[kk * 65 + nn + 1] = v[1]; tile[kk * 65 + nn + 2] = v[2]; tile[kk * 65 + nn + 3] = v[3]; }
        __syncthreads();
        { const int n = tid >> 3, kg = (tid & 7) * 8; u32x4 w;
          w.x = cvt_pk_bf16(tile[(kg + 0) * 65 + n], tile[(kg + 1) * 65 + n]); w.y = cvt_pk_bf16(tile[(kg + 2) * 65 + n], tile[(kg + 3) * 65 + n]);
          w.z = cvt_pk_bf16(tile[(kg + 4) * 65 + n], tile[(kg + 5) * 65 + n]); w.w = cvt_pk_bf16(tile[(kg + 6) * 65 + n], tile[(kg + 7) * 65 + n]);
          *(u32x4*)(dst + (size_t)(n0 + n) * K + k0 + kg) = w; }
        __syncthreads();
    }
}

__device__ void rmsnorm_pass(const Params& p, const int MODE, const float* gain, bf16_t* H) {
    const int tidx_ = otid(), bidx_ = obid();
    const int lane = tidx_ & 63, wid = tidx_ >> 6;
    if (MODE == 0) {
        bf16_t* HS = (bf16_t*)(p.ws + WS_HS);
        f32x4 g4[4];
#pragma unroll
        for (int i = 0; i < 4; ++i) g4[i] = *(const f32x4*)(gain + (lane + 64 * i) * 4);
        for (int task = bidx_ * 8 + wid; task < NBATCH * 768; task += gridDim.x * 8) {
            const int b = task / 768, sI = task % 768;
            bf16_t* hb = HS + (size_t)b * SEQH * D;
            const u32x2 z2 = (u32x2){0u, 0u};
            if (sI > 512) {
#pragma unroll
                for (int i = 0; i < 4; ++i) *(u32x2*)(hb + (size_t)sI * D + (lane + 64 * i) * 4) = z2;
                continue; }
            const bool edge = (sI == 0 || sI == 512);
            const float* q0 = xrow0(p, b * SEQ + sI); const float* q1 = xrow0(p, b * SEQ + sI + 1024);
            const float* q2 = xrow0(p, b * SEQ + (edge ? sI : 1024 - sI)); const float* q3 = xrow0(p, b * SEQ + (edge ? sI + 1024 : 2048 - sI));
            f32x4 v0[4], v1[4], v2[4], v3[4]; float s0 = 0.f, s1 = 0.f, s2 = 0.f, s3 = 0.f;
#pragma unroll
            for (int i = 0; i < 4; ++i) { const int e0 = (lane + 64 * i) * 4; v0[i] = __builtin_nontemporal_load((const f32x4*)(q0 + e0)); v1[i] = __builtin_nontemporal_load((const f32x4*)(q1 + e0)); v2[i] = __builtin_nontemporal_load((const f32x4*)(q2 + e0)); v3[i] = __builtin_nontemporal_load((const f32x4*)(q3 + e0));
                s0 += v0[i][0] * v0[i][0] + v0[i][1] * v0[i][1] + v0[i][2] * v0[i][2] + v0[i][3] * v0[i][3]; s1 += v1[i][0] * v1[i][0] + v1[i][1] * v1[i][1] + v1[i][2] * v1[i][2] + v1[i][3] * v1[i][3];
                s2 += v2[i][0] * v2[i][0] + v2[i][1] * v2[i][1] + v2[i][2] * v2[i][2] + v2[i][3] * v2[i][3]; s3 += v3[i][0] * v3[i][0] + v3[i][1] * v3[i][1] + v3[i][2] * v3[i][2] + v3[i][3] * v3[i][3]; }
#pragma unroll
            for (int o = 32; o >= 1; o >>= 1) { s0 += __shfl_xor(s0, o); s1 += __shfl_xor(s1, o); s2 += __shfl_xor(s2, o); s3 += __shfl_xor(s3, o); }
            const float r0 = rsqrtf(s0 * (1.0f / D) + EPS), r1 = rsqrtf(s1 * (1.0f / D) + EPS), r2 = edge ? 0.f : rsqrtf(s2 * (1.0f / D) + EPS), r3 = edge ? 0.f : rsqrtf(s3 * (1.0f / D) + EPS);
#pragma unroll
            for (int i = 0; i < 4; ++i) { const int e0 = (lane + 64 * i) * 4;
                const f32x4 h0 = v0[i] * r0 * g4[i], h1 = v1[i] * r1 * g4[i], h2 = v2[i] * r2 * g4[i], h3 = v3[i] * r3 * g4[i];
                const f32x4 xe = h0 + h1, xo = h0 - h1, ye = h2 + h3, yo = h2 - h3;
                const f32x4 ec = xe + ye, es = xe - ye, oc = xo - yo, os = xo + yo;
#define HS_ST(row_, val_) do { u32x2 w_; w_.x = cvt_pk_bf16(val_[0], val_[1]); w_.y = cvt_pk_bf16(val_[2], val_[3]); *(u32x2*)(hb + (size_t)(row_) * D + e0) = w_; } while (0)
                HS_ST(sI, ec);
                if (sI == 0) { *(u32x2*)(hb + (size_t)768 * D + e0) = z2; HS_ST(1280, oc); }
                else if (sI == 512) { HS_ST(1791 + 512, os); }
                else { HS_ST(768 + sI, es); HS_ST(1280 + sI, oc); HS_ST(1791 + sI, os); }
#undef HS_ST
            }
        }
    } else {
        f32x4 g4[2][2];
#pragma unroll
        for (int i = 0; i < 2; ++i) { g4[i][0] = *(const f32x4*)(gain + i * 512 + lane * 8); g4[i][1] = *(const f32x4*)(gain + i * 512 + lane * 8 + 4); }
        for (int row0 = bidx_ * 8 + wid; row0 < T; row0 += gridDim.x * 8 * 4) {
          u32x4 wq[4][2];
#pragma unroll
          for (int r = 0; r < 4; ++r)
#pragma unroll
            for (int i = 0; i < 2; ++i) { const int rr_ = row0 + r * (int)gridDim.x * 8; wq[r][i] = *(const u32x4*)(H + (size_t)(rr_ < T ? rr_ : T - 1) * D + i * 512 + lane * 8); }
#pragma unroll
          for (int r = 0; r < 4; ++r) {
            const int row = row0 + r * (int)gridDim.x * 8;
            if (row >= T) continue;
            float v[2][8]; float ss = 0.f;
#pragma unroll
            for (int i = 0; i < 2; ++i) { const u32x4 w = wq[r][i];
#pragma unroll
                for (int q = 0; q < 4; ++q) { v[i][2 * q] = bflo(w[q]); v[i][2 * q + 1] = bfhi(w[q]); ss += v[i][2 * q] * v[i][2 * q] + v[i][2 * q + 1] * v[i][2 * q + 1]; } }
#pragma unroll
            for (int o = 32; o >= 1; o >>= 1) ss += __shfl_xor(ss, o);
            const float rstd = rsqrtf(ss * (1.0f / D) + EPS);
            float* op = p.out + (size_t)row * D;
#pragma unroll
            for (int i = 0; i < 2; ++i) {
                const f32x4 o0 = (f32x4){v[i][0], v[i][1], v[i][2], v[i][3]} * rstd * g4[i][0], o1 = (f32x4){v[i][4], v[i][5], v[i][6], v[i][7]} * rstd * g4[i][1];
                __builtin_nontemporal_store(o0, (f32x4*)(op + i * 512 + lane * 8)); __builtin_nontemporal_store(o1, (f32x4*)(op + i * 512 + lane * 8 + 4)); }
          }
        }
    }
}

__device__ void gen_tables(const Params& p) {
    const int tidx_ = otid(), bidx_ = obid(); (void)tidx_; (void)bidx_;
    const size_t gtid = (size_t)bidx_ * NTHREADS + tidx_, gsz = (size_t)gridDim.x * NTHREADS;
    bf16_t* A2 = (bf16_t*)(p.ws + WS_A2);
    const float sc2 = 0.02209708691207961f;
    for (size_t e = gtid; e < (size_t)1024 * 1280 / 8; e += gsz) {
        const int k = (int)(e / 160), c0 = (int)(e % 160) * 8;
        float v[8];
#pragma unroll
        for (int j = 0; j < 8; ++j) { const int c = c0 + j, sp = c >= 768 ? c - 768 : c; const int ph = (k * sp) & 1023; float sn, cn; sincospif((float)ph * (1.0f / 512.0f), &sn, &cn);
            v[j] = c <= 512 ? cn * sc2 : (c < 768 ? 0.f : -sn * sc2); }
        u32x4 w; w.x = cvt_pk_bf16(v[0], v[1]); w.y = cvt_pk_bf16(v[2], v[3]); w.z = cvt_pk_bf16(v[4], v[5]); w.w = cvt_pk_bf16(v[6], v[7]);
        *(u32x4*)(A2 + e * 8) = w;
    }
    bf16_t* A2o = A2 + (size_t)1024 * 1280;
    for (size_t e = gtid; e < (size_t)1024 * 1024 / 8; e += gsz) {
        const int k = (int)(e / 128), c0 = (int)(e % 128) * 8;
        float v[8];
#pragma unroll
        for (int j = 0; j < 8; ++j) { const int c = c0 + j, sp = c >= 512 ? c - 511 : c; const int ph = ((2 * k + 1) * sp) & 2047; float sn, cn; sincospif((float)ph * (1.0f / 1024.0f), &sn, &cn);
            v[j] = c < 512 ? cn * sc2 : -sn * sc2; }
        u32x4 w; w.x = cvt_pk_bf16(v[0], v[1]); w.y = cvt_pk_bf16(v[2], v[3]); w.z = cvt_pk_bf16(v[4], v[5]); w.w = cvt_pk_bf16(v[6], v[7]);
        *(u32x4*)(A2o + e * 8) = w;
    }
    bf16_t* Dc = (bf16_t*)(p.ws + WS_DFTC);
    for (size_t e = gtid; e < (size_t)512 * 256 / 8; e += gsz) {
        const int r = (int)(e / 32), c0 = (int)(e % 32) * 8, cs = r >> 8, m = r & 255;
        float v[8];
#pragma unroll
        for (int j = 0; j < 8; ++j) { const int ph = (m * (c0 + j)) & 255; float sn, cn; sincospif((float)ph * (1.0f / 128.0f), &sn, &cn); v[j] = (cs ? sn : cn) * 0.0625f; }
        u32x4 w; w.x = cvt_pk_bf16(v[0], v[1]); w.y = cvt_pk_bf16(v[2], v[3]); w.z = cvt_pk_bf16(v[4], v[5]); w.w = cvt_pk_bf16(v[6], v[7]);
        *(u32x4*)(Dc + e * 8) = w;
    }
    f32x2* rope = (f32x2*)(p.ws + WS_ROPE);
    for (size_t e = gtid; e < (size_t)2048 * 16; e += gsz) {
        const int s = (int)(e >> 4), i = (int)(e & 15);
        const float inv = 1.0f / powf(10000.0f, (float)(2 * i) / 32.0f);
        const float ang = (float)s * inv;
        rope[e] = (f32x2){cosf(ang), sinf(ang)};
    }
}

__device__ void mla_mid_pass(const Params& p) {
    const int tidx_ = otid(), bidx_ = obid(); (void)tidx_; (void)bidx_;
    const bf16_t* AA = (const bf16_t*)(p.ws + WS_AA);
    bf16_t* CQ = (bf16_t*)(p.ws + WS_CQ); bf16_t* CKV = (bf16_t*)(p.ws + WS_CKV); bf16_t* KR = (bf16_t*)(p.ws + WS_KR);
    const f32x2* rope = (const f32x2*)(p.ws + WS_ROPE);
    const int lane = tidx_ & 63, wid = tidx_ >> 6;
    float gn[8];
#pragma unroll
    for (int j = 0; j < 8; ++j) gn[j] = lane < 32 ? p.in[5][lane * 8 + j] : (lane < 48 ? p.in[6][(lane - 32) * 8 + j] : 1.0f);
    for (int row0 = bidx_ * 8 + wid; row0 < T; row0 += gridDim.x * 8 * 4) {
        u32x4 wq[4];
#pragma unroll
        for (int r = 0; r < 4; ++r) { const int rr_ = row0 + r * (int)gridDim.x * 8; wq[r] = *(const u32x4*)(AA + (size_t)(rr_ < T ? rr_ : T - 1) * 512 + lane * 8); }
#pragma unroll
        for (int r = 0; r < 4; ++r) {
        const int row = row0 + r * (int)gridDim.x * 8; const u32x4 w = wq[r];
        if (row >= T) continue;
        float v[8];
#pragma unroll
        for (int q = 0; q < 4; ++q) { v[2 * q] = bflo(w[q]); v[2 * q + 1] = bfhi(w[q]); }
        float ss = 0.f;
#pragma unroll
        for (int j = 0; j < 8; ++j) ss += v[j] * v[j];
#pragma unroll
        for (int o = 8; o >= 1; o >>= 1) ss += __shfl_xor(ss, o);
        const float ss32 = ss + __shfl_xor(ss, 16);
        float pv[8];
#pragma unroll
        for (int j = 0; j < 8; ++j) pv[j] = __shfl_xor(v[j], 2);
        if (lane < 32) { const float rstd = rsqrtf(ss32 * (1.0f / 256.0f) + EPS); u32x4 o;
#pragma unroll
            for (int q = 0; q < 4; ++q) o[q] = cvt_pk_bf16(v[2 * q] * rstd * gn[2 * q], v[2 * q + 1] * rstd * gn[2 * q + 1]);
            *(u32x4*)(CQ + (size_t)row * 256 + lane * 8) = o;
        } else if (lane < 48) { const float rstd = rsqrtf(ss * (1.0f / 128.0f) + EPS); u32x4 o;
#pragma unroll
            for (int q = 0; q < 4; ++q) o[q] = cvt_pk_bf16(v[2 * q] * rstd * gn[2 * q], v[2 * q + 1] * rstd * gn[2 * q + 1]);
            *(u32x4*)(CKV + (size_t)row * 128 + (lane - 32) * 8) = o;
        } else if (lane < 52) { const int s = row & (SEQ - 1), l4 = lane - 48, i0 = (l4 & 1) * 8; const bool second = l4 >= 2; float o[8];
#pragma unroll
            for (int j = 0; j < 8; ++j) { const f32x2 cs = rope[s * 16 + i0 + j]; o[j] = second ? (v[j] * cs.x + pv[j] * cs.y) : (v[j] * cs.x - pv[j] * cs.y); }
            u32x4 ow;
#pragma unroll
            for (int q = 0; q < 4; ++q) ow[q] = cvt_pk_bf16(o[2 * q], o[2 * q + 1]);
            *(u32x4*)(KR + (size_t)row * 32 + l4 * 8) = ow;
        }
        }
    }
}

constexpr int KROWB = 208, VROWB = 136, KBUFB = 64 * KROWB, VBUFB = 64 * VROWB;
__device__ __forceinline__ int crow(int r, int hi) { return (r & 3) + 8 * (r >> 2) + 4 * hi; }
__device__ __forceinline__ bf16x8 pack8(const f32x16& x, int s) {
    u32x4 pk; pk.x = cvt_pk_bf16(x[8 * s], x[8 * s + 1]); pk.y = cvt_pk_bf16(x[8 * s + 2], x[8 * s + 3]); pk.z = cvt_pk_bf16(x[8 * s + 4], x[8 * s + 5]); pk.w = cvt_pk_bf16(x[8 * s + 6], x[8 * s + 7]);
    return __builtin_bit_cast(bf16x8, pk);
}
__device__ void attn_phase(const Params& p, LAS unsigned char* lds) {
    const int tidx_ = otid(), bidx_ = obid(); (void)tidx_; (void)bidx_;
    const bf16_t* Q = (const bf16_t*)(p.ws + WS_Q); const bf16_t* KN = (const bf16_t*)(p.ws + WS_KN); const bf16_t* VT = (const bf16_t*)(p.ws + WS_VT);
    const bf16_t* KR = (const bf16_t*)(p.ws + WS_KR); bf16_t* O = (bf16_t*)(p.ws + WS_O);
    const f32x2* rope = (const f32x2*)(p.ws + WS_ROPE);
    const int tid = tidx_, lane = tid & 63, r32 = lane & 31, hi = lane >> 5, wid = tid >> 6;
    const int G = gridDim.x, bx = bidx_, vcu = (G % 8 == 0) ? (bx % 8) * (G / 8) + bx / 8 : bx;
    constexpr int NUNITS = NBATCH * NH * 8, NKT = SEQ / 64;
    for (int u = vcu; u < NUNITS; u += G) {
        const int bh = u >> 3, qb = u & 7, b = bh >> 4, h = bh & 15;
        const int spos = qb * 256 + wid * 32 + r32; const size_t tq = (size_t)b * SEQ + spos;
        bf16x8 qf[6];
#pragma unroll
        for (int d0 = 0; d0 < 6; ++d0) qf[d0] = *(const bf16x8*)(Q + tq * 1536 + h * 96 + d0 * 16 + hi * 8);
        {
            bf16x8 a = qf[4], c = qf[5]; bf16x8 na, nc;
#pragma unroll
            for (int j = 0; j < 8; j += 2) {
                const f32x2 cs0 = rope[spos * 16 + hi * 8 + j], cs1 = rope[spos * 16 + hi * 8 + j + 1];
                const float x10 = bf2f((unsigned short)a[j]), x11 = bf2f((unsigned short)a[j + 1]), x20 = bf2f((unsigned short)c[j]), x21 = bf2f((unsigned short)c[j + 1]);
                const unsigned w1 = cvt_pk_bf16(x10 * cs0.x - x20 * cs0.y, x11 * cs1.x - x21 * cs1.y);
                const unsigned w2 = cvt_pk_bf16(x20 * cs0.x + x10 * cs0.y, x21 * cs1.x + x11 * cs1.y);
                na[j] = (short)(w1 & 0xffff); na[j + 1] = (short)(w1 >> 16); nc[j] = (short)(w2 & 0xffff); nc[j + 1] = (short)(w2 >> 16);
            }
            qf[4] = na; qf[5] = nc;
        }
        float mref = 0.f, lrun = 0.f;
        f32x16 negm;
#pragma unroll
        for (int i = 0; i < 16; ++i) negm[i] = 0.f;
        constexpr float THR = 8.0f;
        f32x16 o0, o1;
#pragma unroll
        for (int i = 0; i < 16; ++i) { o0[i] = 0.f; o1[i] = 0.f; }
        const char* kbase = (const char*)(KN + (size_t)b * SEQ * 1024 + h * 64);
        const char* rbase_ = (const char*)(KR + (size_t)b * SEQ * 32);
        const char* vbase = (const char*)(VT + ((size_t)b * 1024 + h * 64) * 2048);
        const unsigned klane = (unsigned)(((tid >> 3) * 1024 + (tid & 7) * 8) * 2), rlane = (unsigned)(((tid >> 2) * 32 + (tid & 3) * 8) * 2), vlane = (unsigned)(((tid >> 3) * 2048 + (tid & 7) * 8) * 2);
#define KSRC(t_) (kbase + (size_t)(t_) * (64 * 1024 * 2) + klane)
#define RSRC(t_) (rbase_ + (size_t)(t_) * (64 * 32 * 2) + rlane)
#define VSRC(t_) (vbase + (size_t)(t_) * (64 * 2) + vlane)
        const int kdst = (tid >> 3) * KROWB + (tid & 7) * 16, rdst = (tid >> 2) * KROWB + 128 + (tid & 3) * 16, vdst = (tid >> 3) * VROWB + (tid & 7) * 16;
        LAS unsigned char* Kr = lds;
        LAS unsigned char* Vr = lds + 2 * KBUFB;
        u32x4 skA, srA, svA, skB, srB, svB;
        skA = *(const u32x4*)KSRC(0); if (tid < 256) srA = *(const u32x4*)RSRC(0);
        *(LAS u32x4*)(Kr + kdst) = skA; if (tid < 256) *(LAS u32x4*)(Kr + rdst) = srA;
        skA = *(const u32x4*)KSRC(1); if (tid < 256) srA = *(const u32x4*)RSRC(1); svA = *(const u32x4*)VSRC(0);
        skB = *(const u32x4*)KSRC(2); if (tid < 256) srB = *(const u32x4*)RSRC(2); svB = *(const u32x4*)VSRC(1);
        asm volatile("s_waitcnt lgkmcnt(0)\n\ts_barrier" ::: "memory");
        f32x16 pa0, pa1, pb0, pb1;
        {
#pragma unroll
            for (int i = 0; i < 16; ++i) { pa0[i] = negm[i]; pa1[i] = negm[i]; }
#pragma unroll
            for (int d0 = 0; d0 < 6; ++d0) {
                const bf16x8 a0 = *(const LAS bf16x8*)(Kr + r32 * KROWB + (16 * d0 + 8 * hi) * 2);
                const bf16x8 a1 = *(const LAS bf16x8*)(Kr + (32 + r32) * KROWB + (16 * d0 + 8 * hi) * 2);
                pa0 = __builtin_amdgcn_mfma_f32_32x32x16_bf16(a0, qf[d0], pa0, 0, 0, 0);
                pa1 = __builtin_amdgcn_mfma_f32_32x32x16_bf16(a1, qf[d0], pa1, 0, 0, 0);
            }
        }
#define ATT_ITER(kt, SK, SR, SV, PC0, PC1, PN0, PN1) do { \
              \
            LAS unsigned char* Kn = Kr + ((kt + 1) & 1) * KBUFB; LAS unsigned char* Vb = Vr + (kt & 1) * VBUFB; \
            *(LAS u32x4*)(Kn + kdst) = SK; \
            if (tid < 256) *(LAS u32x4*)(Kn + rdst) = SR; \
            *(LAS u32x2*)(Vb + vdst) = (u32x2){SV.x, SV.y}; *(LAS u32x2*)(Vb + vdst + 8) = (u32x2){SV.z, SV.w}; \
            asm volatile("s_waitcnt lgkmcnt(0)\n\ts_barrier" ::: "memory"); \
            { const int k2 = (kt + 3 < NKT) ? kt + 3 : NKT - 1, v1 = (kt + 2 < NKT) ? kt + 2 : NKT - 1;       \
              SK = *(const u32x4*)KSRC(k2); SV = *(const u32x4*)VSRC(v1); if (tid < 256) SR = *(const u32x4*)RSRC(k2); } \
              \
            float mx = fmaxf(fmaxf(PC0[0], PC0[1]), PC1[0]); \
_Pragma("unroll") \
            for (int i = 2; i < 16; i += 2) mx = fmaxf(fmaxf(mx, PC0[i]), PC0[i + 1]); \
_Pragma("unroll") \
            for (int i = 1; i < 16; i += 2) mx = fmaxf(fmaxf(mx, PC1[i]), PC1[i + 1 < 16 ? i + 1 : 0]); \
            { const auto rr = __builtin_amdgcn_permlane32_swap(__float_as_uint(mx), __float_as_uint(mx), false, false); mx = fmaxf(__uint_as_float(rr[0]), __uint_as_float(rr[1])); } \
            if (kt == 0 || __builtin_amdgcn_ballot_w64(mx > THR) != 0ull) {       \
                const float dm = (kt == 0) ? mx : fmaxf(mx, 0.f), alpha = (kt == 0) ? 1.0f : __builtin_amdgcn_exp2f(-dm);     \
                mref += dm; lrun *= alpha; \
_Pragma("unroll") \
                for (int i = 0; i < 16; ++i) { PC0[i] -= dm; PC1[i] -= dm; negm[i] = -mref; } \
_Pragma("unroll") \
                for (int i = 0; i < 16; ++i) { o0[i] *= alpha; o1[i] *= alpha; } \
            } \
              \
_Pragma("unroll") \
            for (int dh3 = 0; dh3 < 2; ++dh3) {         \
                bf16x8 kfa[3], kfb[3]; \
_Pragma("unroll") \
                for (int d1 = 0; d1 < 3; ++d1) { const int d0 = 3 * dh3 + d1; kfa[d1] = *(const LAS bf16x8*)(Kn + r32 * KROWB + (16 * d0 + 8 * hi) * 2); kfb[d1] = *(const LAS bf16x8*)(Kn + (32 + r32) * KROWB + (16 * d0 + 8 * hi) * 2); } \
                __builtin_amdgcn_sched_barrier(0); \
_Pragma("unroll") \
                for (int d1 = 0; d1 < 3; ++d1) { const int d0 = 3 * dh3 + d1; \
                    PN0 = __builtin_amdgcn_mfma_f32_32x32x16_bf16(kfa[d1], qf[d0], d0 == 0 ? negm : PN0, 0, 0, 0);     \
                    PN1 = __builtin_amdgcn_mfma_f32_32x32x16_bf16(kfb[d1], qf[d0], d0 == 0 ? negm : PN1, 0, 0, 0); \
                } \
            } \
            f32x16 e0, e1; \
_Pragma("unroll") \
            for (int i = 0; i < 16; ++i) { e0[i] = __builtin_amdgcn_exp2f(PC0[i]); e1[i] = __builtin_amdgcn_exp2f(PC1[i]); } \
            { const f32x16 es = e0 + e1;        \
              typedef float f32x8_ __attribute__((ext_vector_type(8))); \
              const f32x8_ s8 = __builtin_shufflevector(es, es, 0, 1, 2, 3, 4, 5, 6, 7) + __builtin_shufflevector(es, es, 8, 9, 10, 11, 12, 13, 14, 15); \
              const f32x4 s4 = __builtin_shufflevector(s8, s8, 0, 1, 2, 3) + __builtin_shufflevector(s8, s8, 4, 5, 6, 7); \
              const f32x2 s2 = __builtin_shufflevector(s4, s4, 0, 1) + __builtin_shufflevector(s4, s4, 2, 3); \
              lrun += s2[0] + s2[1]; } \
              \
_Pragma("unroll") \
            for (int kh = 0; kh < 2; ++kh) \
_Pragma("unroll") \
                for (int s = 0; s < 2; ++s) { \
                    const bf16x8 pf = pack8(kh ? e1 : e0, s); \
                      \
                    s16x4 vl0, vh0, vl1, vh1; \
                    { const unsigned va = (unsigned)(size_t)(Vb + r32 * VROWB + hi * 8 + kh * 64 + s * 32); \
                      asm volatile("ds_read_b64 %0, %4\n\tds_read_b64 %1, %4 offset:16\n\tds_read_b64 %2, %4 offset:4352\n\tds_read_b64 %3, %4 offset:4368\n\ts_waitcnt lgkmcnt(0)" \
                                   : "=&v"(vl0), "=&v"(vh0), "=&v"(vl1), "=&v"(vh1) : "v"(va)); } \
                    o0 = __builtin_amdgcn_mfma_f32_32x32x16_bf16(__builtin_shufflevector(vl0, vh0, 0, 1, 2, 3, 4, 5, 6, 7), pf, o0, 0, 0, 0); \
                    o1 = __builtin_amdgcn_mfma_f32_32x32x16_bf16(__builtin_shufflevector(vl1, vh1, 0, 1, 2, 3, 4, 5, 6, 7), pf, o1, 0, 0, 0); \
                } \
        } while (0)
        for (int kt2 = 0; kt2 < NKT; kt2 += 2) { { const int kt = kt2; ATT_ITER(kt, skA, srA, svA, pa0, pa1, pb0, pb1); } { const int kt = kt2 + 1; ATT_ITER(kt, skB, srB, svB, pb0, pb1, pa0, pa1); } }
#undef ATT_ITER
#undef KSRC
#undef RSRC
#undef VSRC
        const float ltot = lrun + __shfl_xor(lrun, 32), inv = 1.0f / ltot;
        bf16_t* op = O + tq * 1024 + h * 64;
#pragma unroll
        for (int dh = 0; dh < 2; ++dh)
#pragma unroll
            for (int g4 = 0; g4 < 4; ++g4) { const f32x16& oo = dh ? o1 : o0; u32x2 w;
                w.x = cvt_pk_bf16(oo[4 * g4] * inv, oo[4 * g4 + 1] * inv); w.y = cvt_pk_bf16(oo[4 * g4 + 2] * inv, oo[4 * g4 + 3] * inv);
                *(u32x2*)(op + dh * 32 + 8 * g4 + 4 * hi) = w; }
    }
    __syncthreads();
}

#define XB_TMO      128
#define XB_XCNT(j)  (256  + 64 * (j))
#define XB_XSUB(j)  (1280 + 64 * (j))
#define XB_XGEN(j)  (2304 + 64 * (j))
#define XB_TOP      3328
#define XB_TOPGEN   3392
#define XCD_BAR_WORDS 3456
#define XB_SPIN_CAP (1u << 18)
__device__ __forceinline__ unsigned xb_ld(unsigned* p)              { return __hip_atomic_load(p, __ATOMIC_RELAXED, __HIP_MEMORY_SCOPE_AGENT); }
__device__ __forceinline__ unsigned xb_add(unsigned* p, unsigned v) { return __hip_atomic_fetch_add(p, v, __ATOMIC_RELAXED, __HIP_MEMORY_SCOPE_AGENT); }
__device__ __forceinline__ unsigned xb_xcc_id() { return (unsigned)__builtin_amdgcn_s_getreg((3 << 11) | 20) & 0xFu; }
#define XB_SPIN(cond, bar) do { unsigned _sp = 0; while (cond) { __builtin_amdgcn_s_sleep(1); \
    if ((++_sp & 255u) == 0u) { if (xb_ld(&(bar)[XB_TMO])) break; if (_sp > XB_SPIN_CAP) { atomicAdd(&(bar)[XB_TMO], 1u); break; } } } } while (0)
struct XcdBarrier { unsigned* bar; unsigned x; volatile LAS unsigned* st; };
__device__ __forceinline__ XcdBarrier xcd_barrier_post(unsigned* bar, volatile LAS unsigned* st) {
    XcdBarrier b; b.bar = bar; b.x = xb_xcc_id(); b.st = st;
    if (threadIdx.x == 0) (void)xb_add(&bar[XB_XCNT(b.x)], 1u);
    return b;
}
__device__ __forceinline__ void xcd_barrier_complete(unsigned* bar, unsigned x, unsigned& nloc, unsigned& nx) {
    const unsigned G = gridDim.x * gridDim.y * gridDim.z;
    unsigned sum, cnt, mine, sp = 0u;
    for (;;) {
        sum = 0u; cnt = 0u; mine = 0u;
#pragma unroll
        for (unsigned j = 0; j < 16; ++j) { const unsigned c = xb_ld(&bar[XB_XCNT(j)]); sum += c; cnt += (c > 0u) ? 1u : 0u; mine = (j == x) ? c : mine; }
        if (sum == G) break;
        __builtin_amdgcn_s_sleep(1);
        if ((++sp & 255u) == 0u) { if (xb_ld(&bar[XB_TMO])) break; if (sp > XB_SPIN_CAP) { atomicAdd(&bar[XB_TMO], 1u); break; } }
    }
    nloc = mine > 0u ? mine : 1u; nx = cnt > 0u ? cnt : 1u;
}
__device__ __forceinline__ void xcd_barrier(const XcdBarrier& b) {
    asm volatile("s_waitcnt vmcnt(0)" ::: "memory");
    __syncthreads();
    if (threadIdx.x == 0) {
        unsigned* bar = b.bar;
        __builtin_amdgcn_s_waitcnt(0);
        unsigned nloc = b.st[0], nx = b.st[1];
        if (nloc == 0u) { xcd_barrier_complete(bar, b.x, nloc, nx); b.st[0] = nloc; b.st[1] = nx; }
        const unsigned old = xb_add(&bar[XB_XSUB(b.x)], 1u);
        const unsigned gen = old / nloc;
        if (old + 1u == (gen + 1u) * nloc) {
            __builtin_amdgcn_fence(__ATOMIC_RELEASE, "agent");
            asm volatile("s_waitcnt vmcnt(0)" ::: "memory");
            const unsigned og = xb_add(&bar[XB_TOP], 1u);
            const unsigned tg = og / nx;
            if (og + 1u == (tg + 1u) * nx) xb_add(&bar[XB_TOPGEN], 1u);
            else XB_SPIN(xb_ld(&bar[XB_TOPGEN]) == tg, bar);
            __builtin_amdgcn_fence(__ATOMIC_ACQUIRE, "agent");
            xb_add(&bar[XB_XGEN(b.x)], 1u);
            asm volatile("s_waitcnt vmcnt(0)" ::: "memory");
        } else {
            XB_SPIN(xb_ld(&bar[XB_XGEN(b.x)]) == gen, bar);
            __builtin_amdgcn_fence(__ATOMIC_ACQUIRE, "agent");
            asm volatile("s_waitcnt vmcnt(0)" ::: "memory");
        }
    }
    __syncthreads();
}

constexpr int NSTEPS = 20;
__device__ __forceinline__ int step_of(int it) { return it <= 2 ? it : (it == 3 ? 19 : it - 1); }
__device__ __forceinline__ bool step_needs_sync(int st) { return st != 11 && st != 12 && st != 19; }
__device__ __forceinline__ bool make_job(const Params& p, int st, GemmJob& j) {
    unsigned char* ws = p.ws; bf16_t* H = (bf16_t*)(ws + WS_H);
    j.bsA = 0; j.bsB = 0; j.bsO = 0; j.xp = p.in[0]; j.xs = p.in[1]; j.nB = 1; j.ldc = 1024; j.ssp = nullptr; j.xb = H; j.gather = 0; j.rs16 = 0; j.cw = nullptr; j.cb = nullptr; j.uh = nullptr;
    float* SSP = (float*)(ws + WS_SSP); float* RSTD = (float*)(ws + WS_RSTD);
    const int layer = st >= 15 ? 1 : 0;
    if (st == 1) { j.A = (const bf16_t*)(ws + WS_DFTC); j.B = (const bf16_t*)(ws + WS_HS); j.lda = 256; j.ldb = 1024; j.bsB = 256; j.K = 256; j.nM = 1; j.nN = NBATCH * 9; j.nB = 4; j.emode = EM_Y1T; j.O = ws + WS_Y1T; j.ldc = SEQH; return true; }
    if (st == 2) { j.A = (const bf16_t*)(ws + WS_A2); j.B = (const bf16_t*)(ws + WS_Y1T); j.lda = 1280; j.ldb = SEQH; j.bsB = (long)1024 * SEQH; j.K = 1280; j.nM = 4; j.nN = 4; j.nB = NBATCH; j.emode = EM_PLAIN; j.O = ws + WS_F; j.bsO = (long)2048 * 1024; j.ldc = 2048; return true; }
    if (st == 19) { j.A = (const bf16_t*)(ws + WS_A2) + (size_t)1024 * 1280; j.B = (const bf16_t*)(ws + WS_Y1T) + 1280; j.lda = 1024; j.ldb = SEQH; j.bsB = (long)1024 * SEQH; j.K = 1024; j.nM = 4; j.nN = 4; j.nB = NBATCH; j.emode = EM_PLAIN; j.O = (bf16_t*)(ws + WS_F) + 1024; j.bsO = (long)2048 * 1024; j.ldc = 2048; return true; }
    if (st == 3) { j.ssp = SSP; j.A = (const bf16_t*)(ws + WS_F); j.B = (const bf16_t*)(ws + WS_WFO); j.lda = 1024; j.ldb = 1024; j.K = 1024; j.nM = T / 256; j.nN = 4; j.emode = EM_RES0; j.O = p.out; return true; }
    if (st == 4 || st == 15) {
        j.A = H; j.B = (const bf16_t*)(ws + (layer ? WS_WUP1 : WS_WUP0)); j.lda = 1024; j.ldb = 1024; j.K = 1024; j.nM = 3; j.nN = FF2 / 256; j.emode = EM_PLAIN; j.O = ws + WS_UH; j.ldc = FF2; j.ssp = SSP; j.rs16 = 1; j.gather = 1; return true; }
    if (st == 5 || st == 16) {
        j.A = H; j.B = (const bf16_t*)(ws + (layer ? WS_WUP1 : WS_WUP0)); j.lda = 1024; j.ldb = 1024; j.K = 1024; j.nM = T / 256; j.nN = FF2 / 256; j.emode = EM_GATE; j.O = ws + WS_G; j.ldc = FF; j.ssp = RSTD;
        j.cw = p.in[12] + (size_t)layer * 3 * FF2; j.cb = p.in[13] + (size_t)layer * FF2; j.uh = (const bf16_t*)(ws + WS_UH); return true; }
    if (st == 6 || st == 17) { j.ssp = SSP; j.A = (const bf16_t*)(ws + WS_G); j.B = (const bf16_t*)(ws + (layer ? WS_WDN1 : WS_WDN0)); j.lda = FF; j.ldb = FF; j.K = FF; j.nM = T / 256; j.nN = 4; j.emode = EM_RES; j.O = p.out; return true; }
    if (st == 8) { j.A = H; j.B = (const bf16_t*)(ws + WS_WIN); j.lda = 1024; j.ldb = 1024; j.K = 1024; j.nM = T / 256; j.nN = 2; j.emode = EM_PLAIN; j.O = ws + WS_AA; j.ldc = 512; j.ssp = RSTD; return true; }
    if (st == 10) { j.A = (const bf16_t*)(ws + WS_CQ); j.B = (const bf16_t*)(ws + WS_WUQ); j.lda = 256; j.ldb = 256; j.K = 256; j.nM = T / 256; j.nN = 6; j.emode = EM_PLAIN; j.O = ws + WS_Q; j.ldc = 1536; return true; }
    if (st == 11) { j.A = (const bf16_t*)(ws + WS_CKV); j.B = (const bf16_t*)(ws + WS_WK); j.lda = 128; j.ldb = 128; j.K = 128; j.nM = T / 256; j.nN = 4; j.emode = EM_PLAIN; j.O = ws + WS_KN; return true; }
    if (st == 12) { j.A = (const bf16_t*)(ws + WS_WV); j.B = (const bf16_t*)(ws + WS_CKV); j.lda = 128; j.ldb = 128; j.K = 128; j.nM = 4; j.nN = T / 256; j.emode = EM_VT; j.O = ws + WS_VT; j.ldc = 2048; return true; }
    if (st == 14) { j.ssp = SSP; j.A = (const bf16_t*)(ws + WS_O); j.B = (const bf16_t*)(ws + WS_WO); j.lda = 1024; j.ldb = 1024; j.K = 1024; j.nM = T / 256; j.nN = 4; j.emode = EM_RES; j.O = p.out; return true; }
    return false;
}
__global__ void __launch_bounds__(NTHREADS, 2) mega(Params p) {
    extern __shared__ __attribute__((aligned(16))) unsigned char smem[];
    LAS unsigned char* lds = (LAS unsigned char*)smem;
    unsigned char* ws = p.ws;
    bf16_t* H = (bf16_t*)(ws + WS_H);
    XcdBarrier xbar; xbar.bar = (unsigned*)(ws + WS_BAR); xbar.x = 0; xbar.st = (volatile LAS unsigned*)(lds + LDS_XB);
    if (p.coop) {
        if (threadIdx.x < 4) ((LAS unsigned*)(lds + LDS_XB))[threadIdx.x] = 0u;
        __syncthreads();
        xbar = xcd_barrier_post((unsigned*)(ws + WS_BAR), (volatile LAS unsigned*)(lds + LDS_XB));
    }
    bool first_sync = true;
    for (int it = p.ph_lo; it < p.ph_hi; ++it) {
        const int st = step_of(it);
        if (it > p.ph_lo && p.coop && step_needs_sync(st)) {
            if (first_sync) { cg::this_grid().sync(); first_sync = false; }
            else xcd_barrier(xbar);
        }
        if (st == 4 || st == 7 || st == 15) {
            const float* SSP = (const float*)(ws + WS_SSP); float* RSTD = (float*)(ws + WS_RSTD);
            for (int row = obid() * NTHREADS + otid(); row < T; row += gridDim.x * NTHREADS) {
                const f32x4* q4 = (const f32x4*)(SSP + (size_t)row * 16); const f32x4 a = q4[0], b = q4[1], c = q4[2], d = q4[3];
                const float ss = ((a[0] + a[1]) + (a[2] + a[3])) + ((b[0] + b[1]) + (b[2] + b[3])) + ((c[0] + c[1]) + (c[2] + c[3])) + ((d[0] + d[1]) + (d[2] + d[3]));
                RSTD[row] = rsqrtf(ss * (1.0f / D) + EPS); }
        }
        GemmJob job;
        if (make_job(p, st, job)) { gemm_phase(lds, job); continue; }
        if (st == 0) {
            float* tile = (float*)smem;
            for (int w = 0; w < 10; ++w) {
                const float* src; const float* ksc = nullptr; float wsc = 1.0f; int K, N, ld, Np, cm = 0; size_t dsto;
                switch (w) {
                    case 0: src = p.in[3]; K = 1024; N = 1024; ld = 1024; Np = 1024; dsto = WS_WFO; break;
                    case 1: src = p.in[4]; K = 1024; N = 416; ld = 416; Np = 512; dsto = WS_WIN; ksc = p.in[2] + D; break;
                    case 2: src = p.in[7]; K = 256; N = 1536; ld = 1536; Np = 1536; dsto = WS_WUQ; wsc = 0.10206207261596577f * 1.4426950408889634f; break;
                    case 3: src = p.in[8]; K = 128; N = 1024; ld = 2048; Np = 1024; cm = 1; dsto = WS_WK; break;
                    case 4: src = p.in[8]; K = 128; N = 1024; ld = 2048; Np = 1024; cm = 2; dsto = WS_WV; break;
                    case 5: src = p.in[9]; K = 1024; N = 1024; ld = 1024; Np = 1024; dsto = WS_WO; break;
                    case 6: src = p.in[11]; K = 1024; N = FF2; ld = FF2; Np = FF2; dsto = WS_WUP0; ksc = p.in[10]; cm = 3; break;
                    case 7: src = p.in[11] + (size_t)1024 * FF2; K = 1024; N = FF2; ld = FF2; Np = FF2; dsto = WS_WUP1; ksc = p.in[10] + D; cm = 3; break;
                    case 8: src = p.in[14]; K = FF; N = 1024; ld = 1024; Np = 1024; dsto = WS_WDN0; break;
                    default: src = p.in[14] + (size_t)FF * 1024; K = FF; N = 1024; ld = 1024; Np = 1024; dsto = WS_WDN1; break;
                }
                transpose_w(src, K, N, ld, (bf16_t*)(ws + dsto), Np, cm, ksc, wsc, tile);
            }
            gen_tables(p);
        }
        if (st == 0 || st == 18) { rmsnorm_pass(p, st == 0 ? 0 : 2, st == 0 ? p.in[2] : p.in[15], H); continue; }
        if (st == 9) { mla_mid_pass(p); continue; }
        if (st == 13) { attn_phase(p, lds); continue; }
    }
}

#ifndef N_LAUNCH_MODE
#define N_LAUNCH_MODE 1
#endif
extern "C" void kernel_launch(void* const* d_in, const int* in_sizes, int n_in, void* d_out, int out_size, void* d_ws, size_t ws_size, hipStream_t stream) {
    static int grid = 0;
    if (grid == 0) {
        if (n_in != 16 || out_size != T * D || ws_size < WS_END) { fprintf(stderr, "kernel_launch: unexpected shapes n_in %d out %d ws %zu (need %zu)\n", n_in, out_size, ws_size, (size_t)WS_END); grid = -1; return; }
        int dev = 0, cus = 0, per_cu = 0;
        hipGetDevice(&dev); hipDeviceGetAttribute(&cus, hipDeviceAttributeMultiprocessorCount, dev);
        if (hipFuncSetAttribute((const void*)mega, hipFuncAttributeMaxDynamicSharedMemorySize, LDS_BYTES) != hipSuccess) { fprintf(stderr, "kernel_launch: hipFuncSetAttribute failed\n"); grid = -1; return; }
        if (hipOccupancyMaxActiveBlocksPerMultiprocessor(&per_cu, (const void*)mega, NTHREADS, LDS_BYTES) != hipSuccess || per_cu < 1) { fprintf(stderr, "kernel_launch: occupancy query says %d\n", per_cu); per_cu = 1; }
        (void)hipGetLastError();
        grid = cus * 1;
    }
    if (grid < 0) return;
    Params p{};
    for (int i = 0; i < 16; ++i) p.in[i] = (const float*)d_in[i];
    p.out = (float*)d_out; p.ws = (unsigned char*)d_ws;
#if N_LAUNCH_MODE == 1
    if (hipMemsetAsync((char*)d_ws + WS_BAR, 0, XCD_BAR_WORDS * 4, stream) != hipSuccess) { fprintf(stderr, "kernel_launch: memset of barrier words failed\n"); return; }
    p.ph_lo = 0; p.ph_hi = NSTEPS; p.coop = 1;
    void* args[] = {&p};
    hipError_t e = hipLaunchCooperativeKernel((const void*)mega, dim3(grid), dim3(NTHREADS), args, LDS_BYTES, stream);
    if (e != hipSuccess) fprintf(stderr, "cooperative launch failed: %s (grid %d)\n", hipGetErrorString(e), grid);
#else
    for (int ph = 0; ph < NSTEPS; ++ph) {
        p.ph_lo = ph; p.ph_hi = ph + 1; p.coop = 0;
        hipLaunchKernelGGL(mega, dim3(grid), dim3(NTHREADS), LDS_BYTES, stream, p);
    }
#endif
}
```

```cpp
#include <hip/hip_runtime.h>
#include <hip/hip_cooperative_groups.h>
#include <cstdio>
#include <cstdint>
namespace cg = cooperative_groups;

#define LAS __attribute__((address_space(3)))
typedef unsigned short bf16_t;
typedef short bf16x8 __attribute__((ext_vector_type(8)));
typedef short s16x4 __attribute__((ext_vector_type(4)));
typedef float f32x4 __attribute__((ext_vector_type(4)));
typedef float f32x2 __attribute__((ext_vector_type(2)));
typedef float f32x16 __attribute__((ext_vector_type(16)));
typedef unsigned u32x4 __attribute__((ext_vector_type(4)));
typedef unsigned u32x2 __attribute__((ext_vector_type(2)));

constexpr int T = 81920, D = 1024, SEQ = 2048, NBATCH = 40, TP = 65536;
constexpr int FF = 2816, FF2 = 5632;
constexpr int NH = 16;
constexpr float EPS = 1e-6f;
constexpr size_t MiB = 1024ull * 1024ull;
constexpr size_t WS_WFO = 0, WS_WIN = 2 * MiB, WS_WUQ = 3 * MiB, WS_WK = 4 * MiB, WS_WV = 4 * MiB + 512 * 1024, WS_WO = 5 * MiB,
                 WS_WUP0 = 7 * MiB, WS_WUP1 = 18 * MiB, WS_WDN0 = 29 * MiB, WS_WDN1 = 35 * MiB, WS_DFTC = 41 * MiB, WS_ROPE = 42 * MiB,
                 WS_A2 = 43 * MiB, WS_SSP = 59 * MiB, WS_H = 64 * MiB, WS_BIG = 224 * MiB;
constexpr size_t WS_BAR = WS_ROPE + 896 * 1024;
constexpr size_t WS_RSTD = WS_ROPE + 512 * 1024;
constexpr size_t WS_Y1T = WS_BIG, WS_F = WS_BIG + 320 * MiB, WS_HS = WS_BIG + 480 * MiB;
constexpr int SEQH = 2304;
constexpr size_t WS_G = WS_BIG, WS_UH = WS_BIG + 440 * MiB;
constexpr size_t WS_Q = WS_BIG, WS_AA = WS_BIG, WS_KN = WS_BIG + 240 * MiB, WS_VT = WS_BIG + 400 * MiB, WS_CQ = WS_BIG + 560 * MiB, WS_CKV = WS_BIG + 600 * MiB,
                 WS_KR = WS_BIG + 620 * MiB, WS_O = WS_BIG + 625 * MiB;
constexpr size_t WS_END = WS_BIG + 785 * MiB;
constexpr int LDS_XB = 131072 + 16384;
constexpr int LDS_SIDE = 131072 + 16384 + 32;
constexpr int LDS_BYTES = LDS_SIDE + 2 * 6144;
constexpr int NTHREADS = 512;

struct Params {
    const float* in[16];
    float* out;
    unsigned char* ws;
    int ph_lo, ph_hi, coop, pad;
};

__device__ __forceinline__ int otid() { int t = threadIdx.x; asm volatile("" : "+v"(t)); return t; }
__device__ __forceinline__ int obid() { int b = blockIdx.x; asm volatile("" : "+s"(b)); return b; }
__device__ __forceinline__ unsigned cvt_pk_bf16(float lo, float hi) { unsigned r; asm volatile("v_cvt_pk_bf16_f32 %0, %1, %2" : "=v"(r) : "v"(lo), "v"(hi)); return r; }
__device__ __forceinline__ float bf2f(unsigned short b) { return __uint_as_float(((unsigned)b) << 16); }
__device__ __forceinline__ float bflo(unsigned w) { return __uint_as_float(w << 16); }
__device__ __forceinline__ float bfhi(unsigned w) { return __uint_as_float(w & 0xffff0000u); }
__device__ __forceinline__ const float* xrow0(const Params& p, int row) { return row < TP ? p.in[0] + (size_t)row * D : p.in[1] + (size_t)(row - TP) * D; }

constexpr int BM = 256, BK = 64, HALF = 128, HTB = HALF * BK * 2, NXCD = 8, WGM = 8;
__device__ __forceinline__ int lds_byte(int r, int c) { const int st = (r >> 4) * 2 + (c >> 5), rr = r & 15, cc = c & 31, ob = rr * 64 + cc * 2; return st * 1024 + (ob ^ (((ob >> 9) & 1) << 5)); }
__device__ __forceinline__ void stage_rc(int b, int& R, int& C) { const int st = b / 1024, sb = b % 1024, swz = sb ^ (((sb >> 9) & 1) << 5); R = (st >> 1) * 16 + swz / 64; C = (st & 1) * 32 + (swz % 64) / 2; }
__device__ __forceinline__ int perm32(int rho) { const int n = rho >> 4, i = rho & 15; return 8 * (i >> 2) + 4 * n + (i & 3); }

struct Unit { int pm, pn, bz; };
__device__ __forceinline__ bool y1t_sin(int vt) { return vt == 3 || vt == 4 || vt >= 7; }
enum { EM_PLAIN = 0, EM_Y1T = 1, EM_VT = 2, EM_GATE = 3, EM_RES0 = 4, EM_RES = 5 };
struct GemmJob { const bf16_t* A; const bf16_t* B; long bsA, bsB, bsO; void* O; const float* xp; const float* xs; float* ssp; bf16_t* xb; const float* cw; const float* cb; const bf16_t* uh; int lda, ldb, K, nM, nN, nB, emode, ldc, gather, rs16; };

struct Sched {
    int nM, nN, nB, nwg, G, c;
    __device__ __forceinline__ void init(int nM_, int nN_, int nB_, int G_, int c_) { nM = nM_; nN = nN_; nB = nB_; nwg = nM * nN * nB; G = G_; c = c_; }
    __device__ __forceinline__ bool next(int i, Unit& u) const {
        const long L = (long)i * G + c; if (L >= nwg) return false;
        int wgid = (int)L; { const int q = nwg / NXCD, r = nwg % NXCD, xcd = wgid % NXCD, off = wgid / NXCD; wgid = (xcd < r ? xcd * (q + 1) : r * (q + 1) + (xcd - r) * q) + off; }
        const int nMf = nM * nB, nig = WGM * nN, gid = wgid / nig, fm = gid * WGM, gsz = (nMf - fm) < WGM ? (nMf - fm) : WGM;
        const int pmf = fm + ((wgid % nig) % gsz); u.pn = (wgid % nig) / gsz; u.bz = pmf / nM; u.pm = pmf % nM; return true;
    }
};

__device__ __forceinline__ float dpp_ror1(float src) { return __int_as_float(__builtin_amdgcn_update_dpp(0, __float_as_int(src), 0x121, 0xf, 0xf, true)); }
__device__ __forceinline__ float dpp_ror15(float src) { return __int_as_float(__builtin_amdgcn_update_dpp(0, __float_as_int(src), 0x12f, 0xf, 0xf, true)); }
__device__ __forceinline__ float dpp_up(float old, float src) { return __int_as_float(__builtin_amdgcn_update_dpp(__float_as_int(old), __float_as_int(src), 0x111, 0xf, 0xf, false)); }
__device__ __forceinline__ float dpp_dn(float old, float src) { return __int_as_float(__builtin_amdgcn_update_dpp(__float_as_int(old), __float_as_int(src), 0x101, 0xf, 0xf, false)); }
__device__ __forceinline__ void epilogue(const GemmJob& g, f32x4 (&acc)[2][2][4][2], const Unit& u, int wr, int wc, int fr_, int fq_, LAS unsigned char* lds, int par) {
    int fr = fr_, fq = fq_; asm volatile("" : "+v"(fr), "+v"(fq));
    if (g.emode == EM_GATE) {
        LAS unsigned char* E = lds + 131072;
        const LAS unsigned char* SD = lds + LDS_SIDE + par * 6144;
        float rsv[2][4];
#pragma unroll
        for (int ai = 0; ai < 2; ++ai)
#pragma unroll
            for (int m = 0; m < 4; ++m) rsv[ai][m] = *(const LAS float*)(SD + (ai * HALF + wr * 64 + m * 16 + fr) * 4);
        const int cl = wc * 32 + 8 * fq;
        const bool e0 = (fr == 0), e15 = (fr == 15);
#pragma unroll
        for (int ai = 0; ai < 2; ++ai)
#pragma unroll
            for (int m = 0; m < 4; ++m) {
                const float rstd = rsv[ai][m];
#pragma unroll
                for (int bj = 0; bj < 2; ++bj)
#pragma unroll
                    for (int n = 0; n < 2; ++n) acc[ai][bj][m][n] = acc[ai][bj][m][n] * rstd;
                if (e0 || e15) { const int er = 2 * (8 * ai + 4 * wr + m) + (e15 ? 1 : 0);
#pragma unroll
                    for (int bj = 0; bj < 2; ++bj) { const f32x4 v0 = acc[ai][bj][m][0], v1 = acc[ai][bj][m][1];
                        u32x4 w; w.x = cvt_pk_bf16(v0[0], v0[1]); w.y = cvt_pk_bf16(v0[2], v0[3]); w.z = cvt_pk_bf16(v1[0], v1[1]); w.w = cvt_pk_bf16(v1[2], v1[3]);
                        *(LAS u32x4*)(E + (er * 256 + bj * HALF + cl) * 2) = w; } }
            }
        asm volatile("s_waitcnt lgkmcnt(0)" ::: "memory"); __builtin_amdgcn_s_barrier(); asm volatile("" ::: "memory");
        const int pmq = u.pm & 7;
        u32x2 keep[2][4];
#pragma unroll
        for (int n = 0; n < 2; ++n) {
            const int f0 = u.pn * 128 + cl;
            f32x4 wg[3], wv[3];
#pragma unroll
            for (int k = 0; k < 3; ++k) { wg[k] = *(const LAS f32x4*)(SD + 1024 + k * 1024 + (cl + 4 * n) * 4); wv[k] = *(const LAS f32x4*)(SD + 1024 + k * 1024 + 512 + (cl + 4 * n) * 4); }
            const f32x4 bg = *(const LAS f32x4*)(SD + 4096 + (cl + 4 * n) * 4), bv = *(const LAS f32x4*)(SD + 4096 + 512 + (cl + 4 * n) * 4);
            bf16_t* gout = (bf16_t*)g.O + (size_t)(u.pm * BM + wr * 64 + fr) * FF + f0;
#pragma unroll
            for (int ai = 0; ai < 2; ++ai)
#pragma unroll
                for (int m = 0; m < 4; ++m) {
                    const int gi = 8 * ai + 4 * wr + m;
                    u32x2 wu[2], wd[2];
                    if (ai == 0 && m == 0 && wr == 0) {
#pragma unroll
                        for (int bj = 0; bj < 2; ++bj) { wu[bj] = (u32x2){0u, 0u}; if (pmq != 0) wu[bj] = *(const LAS u32x2*)(SD + 5120 + (bj * HALF + cl + 4 * n) * 2); }
                    } else {
#pragma unroll
                        for (int bj = 0; bj < 2; ++bj) wu[bj] = *(const LAS u32x2*)(E + ((2 * gi - 1) * 256 + bj * HALF + cl + 4 * n) * 2);
                    }
                    if (ai == 1 && m == 3 && wr == 1) {
#pragma unroll
                        for (int bj = 0; bj < 2; ++bj) { wd[bj] = (u32x2){0u, 0u}; if (pmq != 7) wd[bj] = *(const LAS u32x2*)(SD + 5632 + (bj * HALF + cl + 4 * n) * 2); }
                    } else {
#pragma unroll
                        for (int bj = 0; bj < 2; ++bj) wd[bj] = *(const LAS u32x2*)(E + ((2 * gi + 2) * 256 + bj * HALF + cl + 4 * n) * 2);
                    }
                    float o[4];
#pragma unroll
                    for (int j = 0; j < 4; ++j) {
                        const float cg_ = acc[ai][0][m][n][j], cv_ = acc[ai][1][m][n][j];
                        const unsigned pug = (j < 2) ? wu[0].x : wu[0].y, pdg = (j < 2) ? wd[0].x : wd[0].y, puv = (j < 2) ? wu[1].x : wu[1].y, pdv = (j < 2) ? wd[1].x : wd[1].y;
                        const float eug = (j & 1) ? bfhi(pug) : bflo(pug), edg = (j & 1) ? bfhi(pdg) : bflo(pdg), euv = (j & 1) ? bfhi(puv) : bflo(puv), edv = (j & 1) ? bfhi(pdv) : bflo(pdv);
                        const float ug = dpp_up(eug, cg_), dg = dpp_dn(edg, cg_);
                        const float uv = dpp_up(euv, cv_), dv = dpp_dn(edv, cv_);
                        const float gt = wg[0][j] * ug + wg[1][j] * cg_ + wg[2][j] * dg + bg[j];
                        const float vl = wv[0][j] * uv + wv[1][j] * cv_ + wv[2][j] * dv + bv[j];
                        o[j] = gt * __builtin_amdgcn_rcpf(1.0f + __builtin_amdgcn_exp2f(-1.4426950408889634f * gt)) * vl;
                    }
                    u32x2 ow; ow.x = cvt_pk_bf16(o[0], o[1]); ow.y = cvt_pk_bf16(o[2], o[3]);
                    if (n == 0) keep[ai][m] = ow;
                    else { u32x4 o4; o4.x = keep[ai][m].x; o4.y = keep[ai][m].y; o4.z = ow.x; o4.w = ow.y; *(u32x4*)(gout + (size_t)(ai * HALF + m * 16) * FF) = o4; }
                }
            asm volatile("" ::: "memory");
        }
        return;
    }
    if (g.emode <= EM_VT) {
        bf16_t* O = (bf16_t*)g.O; bf16_t* base;
        if (g.emode == EM_PLAIN) base = O + (size_t)u.bz * g.bsO + (size_t)u.pm * BM * g.ldc + (size_t)u.pn * BM;
        else if (g.emode == EM_Y1T) base = O + ((size_t)(u.pn / 9) * 1024 + (size_t)u.bz * 256) * SEQH + (size_t)(u.pn % 9) * 256;
        else base = O + ((size_t)(u.pn >> 3) * 1024 + (size_t)u.pm * 256) * 2048 + (size_t)(u.pn & 7) * 256;
        unsigned off = (unsigned)((wr * 64 + fr) * g.ldc + wc * 32 + 8 * fq) * 2u;
        const unsigned rstep = (unsigned)(16 * g.ldc) * 2u;
        float rsv[2][4];
#pragma unroll
        for (int ai = 0; ai < 2; ++ai)
#pragma unroll
            for (int m = 0; m < 4; ++m) rsv[ai][m] = 1.0f;
        if (g.ssp != nullptr) {
            if (g.rs16) {
#pragma unroll
                for (int ai = 0; ai < 2; ++ai)
#pragma unroll
                    for (int m = 0; m < 4; ++m) { const int i = u.pm * BM + ai * HALF + wr * 64 + m * 16 + fr, grow = 256 * (i >> 1) + 255 + (i & 1);
                        const f32x4* q4 = (const f32x4*)(g.ssp + (size_t)(grow < T ? grow : T - 1) * 16); const f32x4 a = q4[0], b = q4[1], c = q4[2], d = q4[3];
                        const float ss = ((a[0] + a[1]) + (a[2] + a[3])) + ((b[0] + b[1]) + (b[2] + b[3])) + ((c[0] + c[1]) + (c[2] + c[3])) + ((d[0] + d[1]) + (d[2] + d[3]));
                        rsv[ai][m] = rsqrtf(ss * (1.0f / D) + EPS); }
            } else { const float* sp = g.ssp + (u.pm * BM + wr * 64 + fr);
#pragma unroll
                for (int ai = 0; ai < 2; ++ai)
#pragma unroll
                    for (int m = 0; m < 4; ++m) rsv[ai][m] = sp[ai * HALF + m * 16]; } }
#pragma unroll
        for (int ai = 0; ai < 2; ++ai) {
#pragma unroll
            for (int m = 0; m < 4; ++m) {
                const float rstd = rsv[ai][m];
#pragma unroll
                for (int bj = 0; bj < 2; ++bj) { const f32x4 v0 = acc[ai][bj][m][0] * rstd, v1 = acc[ai][bj][m][1] * rstd;
                    u32x4 w; w.x = cvt_pk_bf16(v0[0], v0[1]); w.y = cvt_pk_bf16(v0[2], v0[3]); w.z = cvt_pk_bf16(v1[0], v1[1]); w.w = cvt_pk_bf16(v1[2], v1[3]);
                    *(u32x4*)((char*)base + off + bj * HALF * 2) = w; }
                off += rstep; }
            off += rstep * 4; }
    } else {
        const int row0 = u.pm * BM;
        bf16_t* xbase = g.xb + (size_t)row0 * D;
        const float* rbase = (row0 < TP ? g.xp + (size_t)row0 * D : g.xs + (size_t)(row0 - TP) * D);
        const unsigned off0 = (unsigned)((wr * 64 + fr) * D + u.pn * BM + wc * 32 + 8 * fq) * 2u;
        float* sp = g.ssp + (size_t)(row0 + wr * 64 + fr) * 16 + u.pn * 4 + wc;
#define RES_OFF(gi_) (off0 + (unsigned)(((gi_) >> 2) * HALF + ((gi_) & 3) * 16) * (unsigned)(D * 2))
#define RES_FIN(gi_, bj_, x0_, x1_) do { u32x4 w; w.x = cvt_pk_bf16(x0_[0], x0_[1]); w.y = cvt_pk_bf16(x0_[2], x0_[3]); w.z = cvt_pk_bf16(x1_[0], x1_[1]); w.w = cvt_pk_bf16(x1_[2], x1_[3]); \
            *(u32x4*)((char*)xbase + RES_OFF(gi_) + (bj_) * HALF * 2) = w; \
            _Pragma("unroll") for (int e_ = 0; e_ < 4; ++e_) { const float ya = bflo(w[e_]), yb = bfhi(w[e_]); ss += ya * ya + yb * yb; } } while (0)
        if (g.emode == EM_RES0) {
#pragma unroll
            for (int gp = 0; gp < 4; ++gp) {
                f32x4 rr[2][2][2];
#pragma unroll
                for (int h2 = 0; h2 < 2; ++h2)
#pragma unroll
                    for (int bj = 0; bj < 2; ++bj)
#pragma unroll
                        for (int n = 0; n < 2; ++n) rr[h2][bj][n] = *(const f32x4*)((const char*)rbase + 2 * (RES_OFF(2 * gp + h2) + bj * HALF * 2) + n * 16);
#pragma unroll
                for (int h2 = 0; h2 < 2; ++h2) {
                    const int gi = 2 * gp + h2, ai = gi >> 2, m = gi & 3;
                    float ss = 0.f;
#pragma unroll
                    for (int bj = 0; bj < 2; ++bj) { const f32x4 x0 = rr[h2][bj][0] + acc[ai][bj][m][0], x1 = rr[h2][bj][1] + acc[ai][bj][m][1]; RES_FIN(gi, bj, x0, x1); }
                    ss += __shfl_xor(ss, 16); ss += __shfl_xor(ss, 32);
                    if (fq == 0) sp[(size_t)(ai * HALF + m * 16) * 16] = ss;
                }
            }
        } else {
            u32x4 ra[4][2], rb[4][2];
#define RES_LOAD(dst, g0_) _Pragma("unroll") for (int m_ = 0; m_ < 4; ++m_) _Pragma("unroll") for (int bj = 0; bj < 2; ++bj) dst[m_][bj] = *(const u32x4*)((const char*)xbase + RES_OFF((g0_) + m_) + bj * HALF * 2)
#define RES_PROC(src, gi_) do { const int gi = (gi_), ai = gi >> 2, m = gi & 3; float ss = 0.f; \
                _Pragma("unroll") for (int bj = 0; bj < 2; ++bj) { const u32x4 rw = src[m][bj]; \
                    const f32x4 x0 = (f32x4){bflo(rw.x), bfhi(rw.x), bflo(rw.y), bfhi(rw.y)} + acc[ai][bj][m][0], x1 = (f32x4){bflo(rw.z), bfhi(rw.z), bflo(rw.w), bfhi(rw.w)} + acc[ai][bj][m][1]; \
                    RES_FIN(gi, bj, x0, x1); } \
                ss += __shfl_xor(ss, 16); ss += __shfl_xor(ss, 32); \
                if (fq == 0) sp[(size_t)(ai * HALF + m * 16) * 16] = ss; } while (0)
            RES_LOAD(ra, 0);
            RES_PROC(ra, 0); RES_PROC(ra, 1);
            RES_LOAD(rb, 4);
            RES_PROC(ra, 2); RES_PROC(ra, 3);
            RES_PROC(rb, 4); RES_PROC(rb, 5); RES_PROC(rb, 6); RES_PROC(rb, 7);
#undef RES_LOAD
#undef RES_PROC
        }
#undef RES_FIN
#undef RES_OFF
    }
}

__device__ __forceinline__ void gemm_phase(LAS unsigned char* lds, const GemmJob& g) {
    Sched S; S.init(g.nM, g.nN, g.nB, (int)gridDim.x, obid());
    int tid = threadIdx.x; asm volatile("" : "+v"(tid));
    const int wid = __builtin_amdgcn_readfirstlane(tid >> 6), lane = tid & 63, wr = wid >> 2, wc = wid & 3, fr = lane & 15, fq = lane >> 4;
    const int K = g.K, nt = K / BK;
    unsigned voffA[2], voffB[2];
#pragma unroll
    for (int i = 0; i < 2; ++i) { int R, C; stage_rc(tid * 16 + i * 8192, R, C); const int Rb = (R & ~31) + perm32(R & 31);
        const int Ra = g.gather ? ((R >> 1) * 256 + 255 + (R & 1)) : R;
        voffA[i] = (unsigned)(Ra * g.lda + C) * 2u; voffB[i] = (unsigned)(Rb * g.ldb + C) * 2u; }
    const size_t kstep = (size_t)(BK * 2);
    const size_t hstepA = (size_t)(g.gather ? 64 * 256 : HALF) * g.lda * 2, hstepB = (size_t)HALF * g.ldb * 2;
    const size_t tstepA = (size_t)(g.gather ? 128 * 256 : BM) * g.lda * 2;
    const unsigned ldsw = (unsigned)wid * 1024u;
    const int aoff = lds_byte(wr * 64 + fr, fq * 8), boff = lds_byte(wc * 32 + fr, fq * 8);
#define PG8_SA(b, h) (((b) * 2 + (h)) * HTB)
#define PG8_SB(b, h) ((4 + (b) * 2 + (h)) * HTB)
#define PG8_STAGE(bufoff, gbase, voff) do { _Pragma("unroll") for (int _i = 0; _i < 2; ++_i) \
        __builtin_amdgcn_global_load_lds((const unsigned*)((const char*)(gbase) + (voff)[_i]), (LAS unsigned*)(lds + (bufoff) + ldsw + _i * 8192), 16, 0, 0); } while (0)
#define PG8_LDA(dst, b, h) do { _Pragma("unroll") for (int m = 0; m < 4; ++m) _Pragma("unroll") for (int k = 0; k < 2; ++k) dst[m][k] = *(const LAS bf16x8*)(lds + PG8_SA(b, h) + aoff + m * 2048 + k * 1024); } while (0)
#define PG8_LDB(dst, b, h) do { _Pragma("unroll") for (int n = 0; n < 2; ++n) _Pragma("unroll") for (int k = 0; k < 2; ++k) dst[n][k] = *(const LAS bf16x8*)(lds + PG8_SB(b, h) + boff + n * 2048 + k * 1024); } while (0)
#define PG8_MMA(ai, bj, At, Bt) do { __builtin_amdgcn_s_setprio(1); _Pragma("unroll") for (int m = 0; m < 4; ++m) _Pragma("unroll") for (int n = 0; n < 2; ++n) _Pragma("unroll") for (int k = 0; k < 2; ++k) \
        acc[ai][bj][m][n] = __builtin_amdgcn_mfma_f32_16x16x32_bf16(Bt[n][k], At[m][k], acc[ai][bj][m][n], 0, 0, 0); __builtin_amdgcn_s_setprio(0); } while (0)
#define PG8_WAIT_V(n) asm volatile("s_waitcnt vmcnt(" #n ")" ::: "memory")
#define PG8_WAIT_L(n) asm volatile("s_waitcnt lgkmcnt(" #n ")" ::: "memory")
#define PG8_BAR __builtin_amdgcn_s_barrier()
#define PG8_SCHED __builtin_amdgcn_sched_barrier(0)
#define PG8_SIDE(U, PAR) do { if (g.emode == EM_GATE && wid < 6) { const int half_ = lane >> 5, l32_ = lane & 31; const char* gp_; \
        if (wid == 0) gp_ = (const char*)(g.ssp + (U).pm * BM) + lane * 16; \
        else if (wid <= 3) gp_ = (const char*)(g.cw + (size_t)(wid - 1) * FF2 + half_ * FF + (U).pn * 128) + l32_ * 16; \
        else if (wid == 4) gp_ = (const char*)(g.cb + half_ * FF + (U).pn * 128) + l32_ * 16; \
        else { const int hr_ = half_ ? 2 * (U).pm + 1 : ((U).pm > 0 ? 2 * ((U).pm - 1) : 0); gp_ = (const char*)(g.uh + (size_t)hr_ * FF2 + (U).pn * BM) + l32_ * 16; } \
        __builtin_amdgcn_global_load_lds((const unsigned*)gp_, (LAS unsigned*)(lds + LDS_SIDE + (PAR) * 6144 + wid * 1024), 16, 0, 0); } } while (0)
    Unit cur, nxt; int ui = 0;
    if (!S.next(0, cur)) return;
    PG8_SIDE(cur, 0);
    f32x4 acc[2][2][4][2];
#pragma unroll
    for (int a = 0; a < 2; ++a)
#pragma unroll
        for (int b = 0; b < 2; ++b)
#pragma unroll
            for (int m = 0; m < 4; ++m)
#pragma unroll
                for (int n = 0; n < 2; ++n) acc[a][b][m][n] = (f32x4){0.f, 0.f, 0.f, 0.f};
    bf16x8 At[4][2], B0[2][2], B1[2][2];
    const char* cA = (const char*)g.A + (size_t)cur.bz * g.bsA * 2 + (size_t)cur.pm * tstepA + ((g.emode == EM_Y1T && y1t_sin(cur.pn % 9)) ? (size_t)256 * 256 * 2 : (size_t)0);
    const char* cB = (const char*)g.B + ((size_t)cur.bz * g.bsB + (size_t)cur.pn * BM * g.ldb) * 2;
    PG8_STAGE(PG8_SB(0, 0), cB, voffB); PG8_STAGE(PG8_SB(0, 1), cB + hstepB, voffB); PG8_STAGE(PG8_SA(0, 0), cA, voffA); PG8_STAGE(PG8_SA(0, 1), cA + hstepA, voffA);
    if (wr == 1) PG8_BAR;
    PG8_WAIT_V(2); PG8_BAR;
    PG8_STAGE(PG8_SB(1, 0), cB + kstep, voffB); PG8_STAGE(PG8_SA(1, 0), cA + kstep, voffA); PG8_STAGE(PG8_SB(1, 1), cB + hstepB + kstep, voffB);
    PG8_WAIT_V(6); PG8_BAR;
    for (;;) {
        const bool has_next = S.next(ui + 1, nxt);
        const char* nA = has_next ? (const char*)g.A + (size_t)nxt.bz * g.bsA * 2 + (size_t)nxt.pm * tstepA + ((g.emode == EM_Y1T && y1t_sin(nxt.pn % 9)) ? (size_t)256 * 256 * 2 : (size_t)0) : cA;
        const char* nB = has_next ? (const char*)g.B + ((size_t)nxt.bz * g.bsB + (size_t)nxt.pn * BM * g.ldb) * 2 : cB;
        for (int t = 0; t < nt; t += 2) {
            const bool last = (t == nt - 2);
            const char* a1 = cA + (size_t)(t + 1) * kstep;
            const char* a2 = last ? nA : cA + (size_t)(t + 2) * kstep; const char* b2 = last ? nB : cB + (size_t)(t + 2) * kstep;
            const char* a3 = a2 + kstep; const char* b3 = b2 + kstep;
            PG8_LDB(B0, 0, 0); PG8_LDB(B1, 0, 1); PG8_SCHED; PG8_LDA(At, 0, 0); PG8_STAGE(PG8_SA(1, 1), a1 + hstepA, voffA);
            PG8_WAIT_V(8); PG8_WAIT_L(0); PG8_BAR; PG8_MMA(0, 0, At, B0); PG8_MMA(0, 1, At, B1); PG8_BAR; PG8_SCHED;
            PG8_LDA(At, 0, 1); PG8_STAGE(PG8_SB(0, 0), b2, voffB); PG8_STAGE(PG8_SB(0, 1), b2 + hstepB, voffB); PG8_STAGE(PG8_SA(0, 0), a2, voffA);
            PG8_WAIT_V(8); PG8_WAIT_L(0); PG8_BAR; PG8_MMA(1, 0, At, B0); PG8_MMA(1, 1, At, B1); PG8_BAR; PG8_SCHED;
            PG8_LDB(B0, 1, 0); PG8_LDB(B1, 1, 1); PG8_SCHED; PG8_LDA(At, 1, 0); PG8_STAGE(PG8_SA(0, 1), a2 + hstepA, voffA);
            PG8_WAIT_V(8); PG8_WAIT_L(0); PG8_BAR; PG8_MMA(0, 0, At, B0); PG8_MMA(0, 1, At, B1); PG8_BAR; PG8_SCHED;
            PG8_LDA(At, 1, 1); PG8_STAGE(PG8_SB(1, 0), b3, voffB); PG8_STAGE(PG8_SB(1, 1), b3 + hstepB, voffB); PG8_STAGE(PG8_SA(1, 0), a3, voffA);
            PG8_WAIT_V(8); PG8_WAIT_L(0); PG8_BAR; PG8_MMA(1, 0, At, B0); PG8_MMA(1, 1, At, B1); PG8_BAR; PG8_SCHED;
        }
        if (wr == 0) PG8_BAR;
        epilogue(g, acc, cur, wr, wc, fr, fq, lds, ui & 1);
        if (!has_next) break;
        PG8_SIDE(nxt, (ui + 1) & 1);
#pragma unroll
        for (int a = 0; a < 2; ++a)
#pragma unroll
            for (int b = 0; b < 2; ++b)
#pragma unroll
                for (int m = 0; m < 4; ++m)
#pragma unroll
                    for (int n = 0; n < 2; ++n) acc[a][b][m][n] = (f32x4){0.f, 0.f, 0.f, 0.f};
        cur = nxt; cA = nA; cB = nB; ++ui;
        if (wr == 1) PG8_BAR;
    }
    PG8_WAIT_V(0);
    PG8_BAR;
#undef PG8_SIDE
#undef PG8_SA
#undef PG8_SB
#undef PG8_STAGE
#undef PG8_LDA
#undef PG8_LDB
#undef PG8_MMA
#undef PG8_WAIT_V
#undef PG8_WAIT_L
#undef PG8_BAR
#undef PG8_SCHED
}

__device__ void transpose_w(const float* src, int K, int N, int ldsrc, bf16_t* dst, int Npad, int cmode, const float* kscale, float wscale, float* tile) {
    const int tidx_ = otid(), bidx_ = obid(); (void)tidx_; (void)bidx_;
    const int tid = tidx_, ntk = K / 64, ntn = Npad / 64;
    for (int t = bidx_; t < ntk * ntn; t += gridDim.x) {
        const int k0 = (t % ntk) * 64, n0 = (t / ntk) * 64;
#pragma unroll
        for (int i = 0; i < 2; ++i) { const int kk = (tid >> 4) + 32 * i, nn = (tid & 15) * 4;
            f32x4 v = (f32x4){0.f, 0.f, 0.f, 0.f};
            const int blk = n0 / 64, c0 = cmode == 0 ? n0 : cmode == 1 ? blk * 128 : cmode == 2 ? blk * 128 + 64 : ((blk >> 1) & 1) * FF + (blk >> 2) * 128 + (blk & 1) * 64;
            if (n0 + nn < N) v = *(const f32x4*)(src + (size_t)(k0 + kk) * ldsrc + c0 + nn);
            v = v * (kscale ? kscale[k0 + kk] * wscale : wscale);
            tile[kk * 65 + nn] = v[0]; tile[kk * 65 + nn + 1] = v[1]; tile[kk * 65 + nn + 2] = v[2]; tile[kk * 65 + nn + 3] = v[3]; }
        __syncthreads();
        { const int n = tid >> 3, kg = (tid & 7) * 8; u32x4 w;
          w.x = cvt_pk_bf16(tile[(kg + 0) * 65 + n], tile[(kg + 1) * 65 + n]); w.y = cvt_pk_bf16(tile[(kg + 2) * 65 + n], tile[(kg + 3) * 65 + n]);
          w.z = cvt_pk_bf16(tile[(kg + 4) * 65 + n], tile[(kg + 5) * 65 + n]); w.w = cvt_pk_bf16(tile[(kg + 6) * 65 + n], tile[(kg + 7) * 65 + n]);
          *(u32x4*)(dst + (size_t)(n0 + n) * K + k0 + kg) = w; }
        __syncthreads();
    }
}

__device__ void rmsnorm_pass(const Params& p, const int MODE, const float* gain, bf16_t* H) {
    const int tidx_ = otid(), bidx_ = obid();
    const int lane = tidx_ & 63, wid = tidx_ >> 6;
    if (MODE == 0) {
        bf16_t* HS = (bf16_t*)(p.ws + WS_HS);
        f32x4 g4[4];
#pragma unroll
        for (int i = 0; i < 4; ++i) g4[i] = *(const f32x4*)(gain + (lane + 64 * i) * 4);
        for (int task = bidx_ * 8 + wid; task < NBATCH * 768; task += gridDim.x * 8) {
            const int b = task / 768, sI = task % 768;
            bf16_t* hb = HS + (size_t)b * SEQH * D;
            const u32x2 z2 = (u32x2){0u, 0u};
            if (sI > 512) {
#pragma unroll
                for (int i = 0; i < 4; ++i) *(u32x2*)(hb + (size_t)sI * D + (lane + 64 * i) * 4) = z2;
                continue; }
            const bool edge = (sI == 0 || sI == 512);
            const float* q0 = xrow0(p, b * SEQ + sI); const float* q1 = xrow0(p, b * SEQ + sI + 1024);
            const float* q2 = xrow0(p, b * SEQ + (edge ? sI : 1024 - sI)); const float* q3 = xrow0(p, b * SEQ + (edge ? sI + 1024 : 2048 - sI));
            f32x4 v0[4], v1[4], v2[4], v3[4]; float s0 = 0.f, s1 = 0.f, s2 = 0.f, s3 = 0.f;
#pragma unroll
            for (int i = 0; i < 4; ++i) { const int e0 = (lane + 64 * i) * 4; v0[i] = __builtin_nontemporal_load((const f32x4*)(q0 + e0)); v1[i] = __builtin_nontemporal_load((const f32x4*)(q1 + e0)); v2[i] = __builtin_nontemporal_load((const f32x4*)(q2 + e0)); v3[i] = __builtin_nontemporal_load((const f32x4*)(q3 + e0));
                s0 += v0[i][0] * v0[i][0] + v0[i][1] * v0[i][1] + v0[i][2] * v0[i][2] + v0[i][3] * v0[i][3]; s1 += v1[i][0] * v1[i][0] + v1[i][1] * v1[i][1] + v1[i][2] * v1[i][2] + v1[i][3] * v1[i][3];
                s2 += v2[i][0] * v2[i][0] + v2[i][1] * v2[i][1] + v2[i][2] * v2[i][2] + v2[i][3] * v2[i][3]; s3 += v3[i][0] * v3[i][0] + v3[i][1] * v3[i][1] + v3[i][2] * v3[i][2] + v3[i][3] * v3[i][3]; }
#pragma unroll
            for (int o = 32; o >= 1; o >>= 1) { s0 += __shfl_xor(s0, o); s1 += __shfl_xor(s1, o); s2 += __shfl_xor(s2, o); s3 += __shfl_xor(s3, o); }
            const float r0 = rsqrtf(s0 * (1.0f / D) + EPS), r1 = rsqrtf(s1 * (1.0f / D) + EPS), r2 = edge ? 0.f : rsqrtf(s2 * (1.0f / D) + EPS), r3 = edge ? 0.f : rsqrtf(s3 * (1.0f / D) + EPS);
#pragma unroll
            for (int i = 0; i < 4; ++i) { const int e0 = (lane + 64 * i) * 4;
                const f32x4 h0 = v0[i] * r0 * g4[i], h1 = v1[i] * r1 * g4[i], h2 = v2[i] * r2 * g4[i], h3 = v3[i] * r3 * g4[i];
                const f32x4 xe = h0 + h1, xo = h0 - h1, ye = h2 + h3, yo = h2 - h3;
                const f32x4 ec = xe + ye, es = xe - ye, oc = xo - yo, os = xo + yo;
#define HS_ST(row_, val_) do { u32x2 w_; w_.x = cvt_pk_bf16(val_[0], val_[1]); w_.y = cvt_pk_bf16(val_[2], val_[3]); *(u32x2*)(hb + (size_t)(row_) * D + e0) = w_; } while (0)
                HS_ST(sI, ec);
                if (sI == 0) { *(u32x2*)(hb + (size_t)768 * D + e0) = z2; HS_ST(1280, oc); }
                else if (sI == 512) { HS_ST(1791 + 512, os); }
                else { HS_ST(768 + sI, es); HS_ST(1280 + sI, oc); HS_ST(1791 + sI, os); }
#undef HS_ST
            }
        }
    } else {
        f32x4 g4[2][2];
#pragma unroll
        for (int i = 0; i < 2; ++i) { g4[i][0] = *(const f32x4*)(gain + i * 512 + lane * 8); g4[i][1] = *(const f32x4*)(gain + i * 512 + lane * 8 + 4); }
        for (int row0 = bidx_ * 8 + wid; row0 < T; row0 += gridDim.x * 8 * 4) {
          u32x4 wq[4][2];
#pragma unroll
          for (int r = 0; r < 4; ++r)
#pragma unroll
            for (int i = 0; i < 2; ++i) { const int rr_ = row0 + r * (int)gridDim.x * 8; wq[r][i] = *(const u32x4*)(H + (size_t)(rr_ < T ? rr_ : T - 1) * D + i * 512 + lane * 8); }
#pragma unroll
          for (int r = 0; r < 4; ++r) {
            const int row = row0 + r * (int)gridDim.x * 8;
            if (row >= T) continue;
            float v[2][8]; float ss = 0.f;
#pragma unroll
            for (int i = 0; i < 2; ++i) { const u32x4 w = wq[r][i];
#pragma unroll
                for (int q = 0; q < 4; ++q) { v[i][2 * q] = bflo(w[q]); v[i][2 * q + 1] = bfhi(w[q]); ss += v[i][2 * q] * v[i][2 * q] + v[i][2 * q + 1] * v[i][2 * q + 1]; } }
#pragma unroll
            for (int o = 32; o >= 1; o >>= 1) ss += __shfl_xor(ss, o);
            const float rstd = rsqrtf(ss * (1.0f / D) + EPS);
            float* op = p.out + (size_t)row * D;
#pragma unroll
            for (int i = 0; i < 2; ++i) {
                const f32x4 o0 = (f32x4){v[i][0], v[i][1], v[i][2], v[i][3]} * rstd * g4[i][0], o1 = (f32x4){v[i][4], v[i][5], v[i][6], v[i][7]} * rstd * g4[i][1];
                __builtin_nontemporal_store(o0, (f32x4*)(op + i * 512 + lane * 8)); __builtin_nontemporal_store(o1, (f32x4*)(op + i * 512 + lane * 8 + 4)); }
          }
        }
    }
}

__device__ void gen_tables(const Params& p) {
    const int tidx_ = otid(), bidx_ = obid(); (void)tidx_; (void)bidx_;
    const size_t gtid = (size_t)bidx_ * NTHREADS + tidx_, gsz = (size_t)gridDim.x * NTHREADS;
    bf16_t* A2 = (bf16_t*)(p.ws + WS_A2);
    const float sc2 = 0.02209708691207961f;
    for (size_t e = gtid; e < (size_t)1024 * 1280 / 8; e += gsz) {
        const int k = (int)(e / 160), c0 = (int)(e % 160) * 8;
        float v[8];
#pragma unroll
        for (int j = 0; j < 8; ++j) { const int c = c0 + j, sp = c >= 768 ? c - 768 : c; const int ph = (k * sp) & 1023; float sn, cn; sincospif((float)ph * (1.0f / 512.0f), &sn, &cn);
            v[j] = c <= 512 ? cn * sc2 : (c < 768 ? 0.f : -sn * sc2); }
        u32x4 w; w.x = cvt_pk_bf16(v[0], v[1]); w.y = cvt_pk_bf16(v[2], v[3]); w.z = cvt_pk_bf16(v[4], v[5]); w.w = cvt_pk_bf16(v[6], v[7]);
        *(u32x4*)(A2 + e * 8) = w;
    }
    bf16_t* A2o = A2 + (size_t)1024 * 1280;
    for (size_t e = gtid; e < (size_t)1024 * 1024 / 8; e += gsz) {
        const int k = (int)(e / 128), c0 = (int)(e % 128) * 8;
        float v[8];
#pragma unroll
        for (int j = 0; j < 8; ++j) { const int c = c0 + j, sp = c >= 512 ? c - 511 : c; const int ph = ((2 * k + 1) * sp) & 2047; float sn, cn; sincospif((float)ph * (1.0f / 1024.0f), &sn, &cn);
            v[j] = c < 512 ? cn * sc2 : -sn * sc2; }
        u32x4 w; w.x = cvt_pk_bf16(v[0], v[1]); w.y = cvt_pk_bf16(v[2], v[3]); w.z = cvt_pk_bf16(v[4], v[5]); w.w = cvt_pk_bf16(v[6], v[7]);
        *(u32x4*)(A2o + e * 8) = w;
    }
    bf16_t* Dc = (bf16_t*)(p.ws + WS_DFTC);
    for (size_t e = gtid; e < (size_t)512 * 256 / 8; e += gsz) {
        const int r = (int)(e / 32), c0 = (int)(e % 32) * 8, cs = r >> 8, m = r & 255;
        float v[8];
#pragma unroll
        for (int j = 0; j < 8; ++j) { const int ph = (m * (c0 + j)) & 255; float sn, cn; sincospif((float)ph * (1.0f / 128.0f), &sn, &cn); v[j] = (cs ? sn : cn) * 0.0625f; }
        u32x4 w; w.x = cvt_pk_bf16(v[0], v[1]); w.y = cvt_pk_bf16(v[2], v[3]); w.z = cvt_pk_bf16(v[4], v[5]); w.w = cvt_pk_bf16(v[6], v[7]);
        *(u32x4*)(Dc + e * 8) = w;
    }
    f32x2* rope = (f32x2*)(p.ws + WS_ROPE);
    for (size_t e = gtid; e < (size_t)2048 * 16; e += gsz) {
        const int s = (int)(e >> 4), i = (int)(e & 15);
        const float inv = 1.0f / powf(10000.0f, (float)(2 * i) / 32.0f);
        const float ang = (float)s * inv;
        rope[e] = (f32x2){cosf(ang), sinf(ang)};
    }
}

__device__ void mla_mid_pass(const Params& p) {
    const int tidx_ = otid(), bidx_ = obid(); (void)tidx_; (void)bidx_;
    const bf16_t* AA = (const bf16_t*)(p.ws + WS_AA);
    bf16_t* CQ = (bf16_t*)(p.ws + WS_CQ); bf16_t* CKV = (bf16_t*)(p.ws + WS_CKV); bf16_t* KR = (bf16_t*)(p.ws + WS_KR);
    const f32x2* rope = (const f32x2*)(p.ws + WS_ROPE);
    const int lane = tidx_ & 63, wid = tidx_ >> 6;
    float gn[8];
#pragma unroll
    for (int j = 0; j < 8; ++j) gn[j] = lane < 32 ? p.in[5][lane * 8 + j] : (lane < 48 ? p.in[6][(lane - 32) * 8 + j] : 1.0f);
    for (int row0 = bidx_ * 8 + wid; row0 < T; row0 += gridDim.x * 8 * 4) {
        u32x4 wq[4];
#pragma unroll
        for (int r = 0; r < 4; ++r) { const int rr_ = row0 + r * (int)gridDim.x * 8; wq[r] = *(const u32x4*)(AA + (size_t)(rr_ < T ? rr_ : T - 1) * 512 + lane * 8); }
#pragma unroll
        for (int r = 0; r < 4; ++r) {
        const int row = row0 + r * (int)gridDim.x * 8; const u32x4 w = wq[r];
        if (row >= T) continue;
        float v[8];
#pragma unroll
        for (int q = 0; q < 4; ++q) { v[2 * q] = bflo(w[q]); v[2 * q + 1] = bfhi(w[q]); }
        float ss = 0.f;
#pragma unroll
        for (int j = 0; j < 8; ++j) ss += v[j] * v[j];
#pragma unroll
        for (int o = 8; o >= 1; o >>= 1) ss += __shfl_xor(ss, o);
        const float ss32 = ss + __shfl_xor(ss, 16);
        float pv[8];
#pragma unroll
        for (int j = 0; j < 8; ++j) pv[j] = __shfl_xor(v[j], 2);
        if (lane < 32) { const float rstd = rsqrtf(ss32 * (1.0f / 256.0f) + EPS); u32x4 o;
#pragma unroll
            for (int q = 0; q < 4; ++q) o[q] = cvt_pk_bf16(v[2 * q] * rstd * gn[2 * q], v[2 * q + 1] * rstd * gn[2 * q + 1]);
            *(u32x4*)(CQ + (size_t)row * 256 + lane * 8) = o;
        } else if (lane < 48) { const float rstd = rsqrtf(ss * (1.0f / 128.0f) + EPS); u32x4 o;
#pragma unroll
            for (int q = 0; q < 4; ++q) o[q] = cvt_pk_bf16(v[2 * q] * rstd * gn[2 * q], v[2 * q + 1] * rstd * gn[2 * q + 1]);
            *(u32x4*)(CKV + (size_t)row * 128 + (lane - 32) * 8) = o;
        } else if (lane < 52) { const int s = row & (SEQ - 1), l4 = lane - 48, i0 = (l4 & 1) * 8; const bool second = l4 >= 2; float o[8];
#pragma unroll
            for (int j = 0; j < 8; ++j) { const f32x2 cs = rope[s * 16 + i0 + j]; o[j] = second ? (v[j] * cs.x + pv[j] * cs.y) : (v[j] * cs.x - pv[j] * cs.y); }
            u32x4 ow;
#pragma unroll
            for (int q = 0; q < 4; ++q) ow[q] = cvt_pk_bf16(o[2 * q], o[2 * q + 1]);
            *(u32x4*)(KR + (size_t)row * 32 + l4 * 8) = ow;
        }
        }
    }
}

constexpr int KROWB = 208, VROWB = 136, KBUFB = 64 * KROWB, VBUFB = 64 * VROWB;
__device__ __forceinline__ int crow(int r, int hi) { return (r & 3) + 8 * (r >> 2) + 4 * hi; }
__device__ __forceinline__ bf16x8 pack8(const f32x16& x, int s) {
    u32x4 pk; pk.x = cvt_pk_bf16(x[8 * s], x[8 * s + 1]); pk.y = cvt_pk_bf16(x[8 * s + 2], x[8 * s + 3]); pk.z = cvt_pk_bf16(x[8 * s + 4], x[8 * s + 5]); pk.w = cvt_pk_bf16(x[8 * s + 6], x[8 * s + 7]);
    return __builtin_bit_cast(bf16x8, pk);
}
__device__ void attn_phase(const Params& p, LAS unsigned char* lds) {
    const int tidx_ = otid(), bidx_ = obid(); (void)tidx_; (void)bidx_;
    const bf16_t* Q = (const bf16_t*)(p.ws + WS_Q); const bf16_t* KN = (const bf16_t*)(p.ws + WS_KN); const bf16_t* VT = (const bf16_t*)(p.ws + WS_VT);
    const bf16_t* KR = (const bf16_t*)(p.ws + WS_KR); bf16_t* O = (bf16_t*)(p.ws + WS_O);
    const f32x2* rope = (const f32x2*)(p.ws + WS_ROPE);
    const int tid = tidx_, lane = tid & 63, r32 = lane & 31, hi = lane >> 5, wid = tid >> 6;
    const int G = gridDim.x, bx = bidx_, vcu = (G % 8 == 0) ? (bx % 8) * (G / 8) + bx / 8 : bx;
    constexpr int NUNITS = NBATCH * NH * 8, NKT = SEQ / 64;
    for (int u = vcu; u < NUNITS; u += G) {
        const int bh = u >> 3, qb = u & 7, b = bh >> 4, h = bh & 15;
        const int spos = qb * 256 + wid * 32 + r32; const size_t tq = (size_t)b * SEQ + spos;
        bf16x8 qf[6];
#pragma unroll
        for (int d0 = 0; d0 < 6; ++d0) qf[d0] = *(const bf16x8*)(Q + tq * 1536 + h * 96 + d0 * 16 + hi * 8);
        {
            bf16x8 a = qf[4], c = qf[5]; bf16x8 na, nc;
#pragma unroll
            for (int j = 0; j < 8; j += 2) {
                const f32x2 cs0 = rope[spos * 16 + hi * 8 + j], cs1 = rope[spos * 16 + hi * 8 + j + 1];
                const float x10 = bf2f((unsigned short)a[j]), x11 = bf2f((unsigned short)a[j + 1]), x20 = bf2f((unsigned short)c[j]), x21 = bf2f((unsigned short)c[j + 1]);
                const unsigned w1 = cvt_pk_bf16(x10 * cs0.x - x20 * cs0.y, x11 * cs1.x - x21 * cs1.y);
                const unsigned w2 = cvt_pk_bf16(x20 * cs0.x + x10 * cs0.y, x21 * cs1.x + x11 * cs1.y);
                na[j] = (short)(w1 & 0xffff); na[j + 1] = (short)(w1 >> 16); nc[j] = (short)(w2 & 0xffff); nc[j + 1] = (short)(w2 >> 16);
            }
            qf[4] = na; qf[5] = nc;
        }
        float mref = 0.f, lrun = 0.f;
        f32x16 negm;
#pragma unroll
        for (int i = 0; i < 16; ++i) negm[i] = 0.f;
        constexpr float THR = 8.0f;
        f32x16 o0, o1;
#pragma unroll
        for (int i = 0; i < 16; ++i) { o0[i] = 0.f; o1[i] = 0.f; }
        const char* kbase = (const char*)(KN + (size_t)b * SEQ * 1024 + h * 64);
        const char* rbase_ = (const char*)(KR + (size_t)b * SEQ * 32);
        const char* vbase = (const char*)(VT + ((size_t)b * 1024 + h * 64) * 2048);
        const unsigned klane = (unsigned)(((tid >> 3) * 1024 + (tid & 7) * 8) * 2), rlane = (unsigned)(((tid >> 2) * 32 + (tid & 3) * 8) * 2), vlane = (unsigned)(((tid >> 3) * 2048 + (tid & 7) * 8) * 2);
#define KSRC(t_) (kbase + (size_t)(t_) * (64 * 1024 * 2) + klane)
#define RSRC(t_) (rbase_ + (size_t)(t_) * (64 * 32 * 2) + rlane)
#define VSRC(t_) (vbase + (size_t)(t_) * (64 * 2) + vlane)
        const int kdst = (tid >> 3) * KROWB + (tid & 7) * 16, rdst = (tid >> 2) * KROWB + 128 + (tid & 3) * 16, vdst = (tid >> 3) * VROWB + (tid & 7) * 16;
        LAS unsigned char* Kr = lds;
        LAS unsigned char* Vr = lds + 2 * KBUFB;
        u32x4 skA, srA, svA, skB, srB, svB;
        skA = *(const u32x4*)KSRC(0); if (tid < 256) srA = *(const u32x4*)RSRC(0);
        *(LAS u32x4*)(Kr + kdst) = skA; if (tid < 256) *(LAS u32x4*)(Kr + rdst) = srA;
        skA = *(const u32x4*)KSRC(1); if (tid < 256) srA = *(const u32x4*)RSRC(1); svA = *(const u32x4*)VSRC(0);
        skB = *(const u32x4*)KSRC(2); if (tid < 256) srB = *(const u32x4*)RSRC(2); svB = *(const u32x4*)VSRC(1);
        asm volatile("s_waitcnt lgkmcnt(0)\n\ts_barrier" ::: "memory");
        f32x16 pa0, pa1, pb0, pb1;
        {
#pragma unroll
            for (int i = 0; i < 16; ++i) { pa0[i] = negm[i]; pa1[i] = negm[i]; }
#pragma unroll
            for (int d0 = 0; d0 < 6; ++d0) {
                const bf16x8 a0 = *(const LAS bf16x8*)(Kr + r32 * KROWB + (16 * d0 + 8 * hi) * 2);
                const bf16x8 a1 = *(const LAS bf16x8*)(Kr + (32 + r32) * KROWB + (16 * d0 + 8 * hi) * 2);
                pa0 = __builtin_amdgcn_mfma_f32_32x32x16_bf16(a0, qf[d0], pa0, 0, 0, 0);
                pa1 = __builtin_amdgcn_mfma_f32_32x32x16_bf16(a1, qf[d0], pa1, 0, 0, 0);
            }
        }
#define ATT_ITER(kt, SK, SR, SV, PC0, PC1, PN0, PN1) do { \
              \
            LAS unsigned char* Kn = Kr + ((kt + 1) & 1) * KBUFB; LAS unsigned char* Vb = Vr + (kt & 1) * VBUFB; \
            *(LAS u32x4*)(Kn + kdst) = SK; \
            if (tid < 256) *(LAS u32x4*)(Kn + rdst) = SR; \
            *(LAS u32x2*)(Vb + vdst) = (u32x2){SV.x, SV.y}; *(LAS u32x2*)(Vb + vdst + 8) = (u32x2){SV.z, SV.w}; \
            asm volatile("s_waitcnt lgkmcnt(0)\n\ts_barrier" ::: "memory"); \
            { const int k2 = (kt + 3 < NKT) ? kt + 3 : NKT - 1, v1 = (kt + 2 < NKT) ? kt + 2 : NKT - 1;       \
              SK = *(const u32x4*)KSRC(k2); SV = *(const u32x4*)VSRC(v1); if (tid < 256) SR = *(const u32x4*)RSRC(k2); } \
              \
            float mx = fmaxf(fmaxf(PC0[0], PC0[1]), PC1[0]); \
_Pragma("unroll") \
            for (int i = 2; i < 16; i += 2) mx = fmaxf(fmaxf(mx, PC0[i]), PC0[i + 1]); \
_Pragma("unroll") \
            for (int i = 1; i < 16; i += 2) mx = fmaxf(fmaxf(mx, PC1[i]), PC1[i + 1 < 16 ? i + 1 : 0]); \
            { const auto rr = __builtin_amdgcn_permlane32_swap(__float_as_uint(mx), __float_as_uint(mx), false, false); mx = fmaxf(__uint_as_float(rr[0]), __uint_as_float(rr[1])); } \
            if (kt == 0 || __builtin_amdgcn_ballot_w64(mx > THR) != 0ull) {       \
                const float dm = (kt == 0) ? mx : fmaxf(mx, 0.f), alpha = (kt == 0) ? 1.0f : __builtin_amdgcn_exp2f(-dm);     \
                mref += dm; lrun *= alpha; \
_Pragma("unroll") \
                for (int i = 0; i < 16; ++i) { PC0[i] -= dm; PC1[i] -= dm; negm[i] = -mref; } \
_Pragma("unroll") \
                for (int i = 0; i < 16; ++i) { o0[i] *= alpha; o1[i] *= alpha; } \
            } \
              \
_Pragma("unroll") \
            for (int dh3 = 0; dh3 < 2; ++dh3) {         \
                bf16x8 kfa[3], kfb[3]; \
_Pragma("unroll") \
                for (int d1 = 0; d1 < 3; ++d1) { const int d0 = 3 * dh3 + d1; kfa[d1] = *(const LAS bf16x8*)(Kn + r32 * KROWB + (16 * d0 + 8 * hi) * 2); kfb[d1] = *(const LAS bf16x8*)(Kn + (32 + r32) * KROWB + (16 * d0 + 8 * hi) * 2); } \
                __builtin_amdgcn_sched_barrier(0); \
_Pragma("unroll") \
                for (int d1 = 0; d1 < 3; ++d1) { const int d0 = 3 * dh3 + d1; \
                    PN0 = __builtin_amdgcn_mfma_f32_32x32x16_bf16(kfa[d1], qf[d0], d0 == 0 ? negm : PN0, 0, 0, 0);     \
                    PN1 = __builtin_amdgcn_mfma_f32_32x32x16_bf16(kfb[d1], qf[d0], d0 == 0 ? negm : PN1, 0, 0, 0); \
                } \
            } \
            f32x16 e0, e1; \
_Pragma("unroll") \
            for (int i = 0; i < 16; ++i) { e0[i] = __builtin_amdgcn_exp2f(PC0[i]); e1[i] = __builtin_amdgcn_exp2f(PC1[i]); } \
            { const f32x16 es = e0 + e1;        \
              typedef float f32x8_ __attribute__((ext_vector_type(8))); \
              const f32x8_ s8 = __builtin_shufflevector(es, es, 0, 1, 2, 3, 4, 5, 6, 7) + __builtin_shufflevector(es, es, 8, 9, 10, 11, 12, 13, 14, 15); \
              const f32x4 s4 = __builtin_shufflevector(s8, s8, 0, 1, 2, 3) + __builtin_shufflevector(s8, s8, 4, 5, 6, 7); \
              const f32x2 s2 = __builtin_shufflevector(s4, s4, 0, 1) + __builtin_shufflevector(s4, s4, 2, 3); \
              lrun += s2[0] + s2[1]; } \
              \
_Pragma("unroll") \
            for (int kh = 0; kh < 2; ++kh) \
_Pragma("unroll") \
                for (int s = 0; s < 2; ++s) { \
                    const bf16x8 pf = pack8(kh ? e1 : e0, s); \
                      \
                    s16x4 vl0, vh0, vl1, vh1; \
                    { const unsigned va = (unsigned)(size_t)(Vb + r32 * VROWB + hi * 8 + kh * 64 + s * 32); \
                      asm volatile("ds_read_b64 %0, %4\n\tds_read_b64 %1, %4 offset:16\n\tds_read_b64 %2, %4 offset:4352\n\tds_read_b64 %3, %4 offset:4368\n\ts_waitcnt lgkmcnt(0)" \
                                   : "=&v"(vl0), "=&v"(vh0), "=&v"(vl1), "=&v"(vh1) : "v"(va)); } \
                    o0 = __builtin_amdgcn_mfma_f32_32x32x16_bf16(__builtin_shufflevector(vl0, vh0, 0, 1, 2, 3, 4, 5, 6, 7), pf, o0, 0, 0, 0); \
                    o1 = __builtin_amdgcn_mfma_f32_32x32x16_bf16(__builtin_shufflevector(vl1, vh1, 0, 1, 2, 3, 4, 5, 6, 7), pf, o1, 0, 0, 0); \
                } \
        } while (0)
        for (int kt2 = 0; kt2 < NKT; kt2 += 2) { { const int kt = kt2; ATT_ITER(kt, skA, srA, svA, pa0, pa1, pb0, pb1); } { const int kt = kt2 + 1; ATT_ITER(kt, skB, srB, svB, pb0, pb1, pa0, pa1); } }
#undef ATT_ITER
#undef KSRC
#undef RSRC
#undef VSRC
        const float ltot = lrun + __shfl_xor(lrun, 32), inv = 1.0f / ltot;
        bf16_t* op = O + tq * 1024 + h * 64;
#pragma unroll
        for (int dh = 0; dh < 2; ++dh)
#pragma unroll
            for (int g4 = 0; g4 < 4; ++g4) { const f32x16& oo = dh ? o1 : o0; u32x2 w;
                w.x = cvt_pk_bf16(oo[4 * g4] * inv, oo[4 * g4 + 1] * inv); w.y = cvt_pk_bf16(oo[4 * g4 + 2] * inv, oo[4 * g4 + 3] * inv);
                *(u32x2*)(op + dh * 32 + 8 * g4 + 4 * hi) = w; }
    }
    __syncthreads();
}

#define XB_TMO      128
#define XB_XCNT(j)  (256  + 64 * (j))
#define XB_XSUB(j)  (1280 + 64 * (j))
#define XB_XGEN(j)  (2304 + 64 * (j))
#define XB_TOP      3328
#define XB_TOPGEN   3392
#define XCD_BAR_WORDS 3456
#define XB_SPIN_CAP (1u << 18)
__device__ __forceinline__ unsigned xb_ld(unsigned* p)              { return __hip_atomic_load(p, __ATOMIC_RELAXED, __HIP_MEMORY_SCOPE_AGENT); }
__device__ __forceinline__ unsigned xb_add(unsigned* p, unsigned v) { return __hip_atomic_fetch_add(p, v, __ATOMIC_RELAXED, __HIP_MEMORY_SCOPE_AGENT); }
__device__ __forceinline__ unsigned xb_xcc_id() { return (unsigned)__builtin_amdgcn_s_getreg((3 << 11) | 20) & 0xFu; }
#define XB_SPIN(cond, bar) do { unsigned _sp = 0; while (cond) { __builtin_amdgcn_s_sleep(1); \
    if ((++_sp & 255u) == 0u) { if (xb_ld(&(bar)[XB_TMO])) break; if (_sp > XB_SPIN_CAP) { atomicAdd(&(bar)[XB_TMO], 1u); break; } } } } while (0)
struct XcdBarrier { unsigned* bar; unsigned x; volatile LAS unsigned* st; };
__device__ __forceinline__ XcdBarrier xcd_barrier_post(unsigned* bar, volatile LAS unsigned* st) {
    XcdBarrier b; b.bar = bar; b.x = xb_xcc_id(); b.st = st;
    if (threadIdx.x == 0) (void)xb_add(&bar[XB_XCNT(b.x)], 1u);
    return b;
}
__device__ __forceinline__ void xcd_barrier_complete(unsigned* bar, unsigned x, unsigned& nloc, unsigned& nx) {
    const unsigned G = gridDim.x * gridDim.y * gridDim.z;
    unsigned sum, cnt, mine, sp = 0u;
    for (;;) {
        sum = 0u; cnt = 0u; mine = 0u;
#pragma unroll
        for (unsigned j = 0; j < 16; ++j) { const unsigned c = xb_ld(&bar[XB_XCNT(j)]); sum += c; cnt += (c > 0u) ? 1u : 0u; mine = (j == x) ? c : mine; }
        if (sum == G) break;
        __builtin_amdgcn_s_sleep(1);
        if ((++sp & 255u) == 0u) { if (xb_ld(&bar[XB_TMO])) break; if (sp > XB_SPIN_CAP) { atomicAdd(&bar[XB_TMO], 1u); break; } }
    }
    nloc = mine > 0u ? mine : 1u; nx = cnt > 0u ? cnt : 1u;
}
__device__ __forceinline__ void xcd_barrier(const XcdBarrier& b) {
    asm volatile("s_waitcnt vmcnt(0)" ::: "memory");
    __syncthreads();
    if (threadIdx.x == 0) {
        unsigned* bar = b.bar;
        __builtin_amdgcn_s_waitcnt(0);
        unsigned nloc = b.st[0], nx = b.st[1];
        if (nloc == 0u) { xcd_barrier_complete(bar, b.x, nloc, nx); b.st[0] = nloc; b.st[1] = nx; }
        const unsigned old = xb_add(&bar[XB_XSUB(b.x)], 1u);
        const unsigned gen = old / nloc;
        if (old + 1u == (gen + 1u) * nloc) {
            __builtin_amdgcn_fence(__ATOMIC_RELEASE, "agent");
            asm volatile("s_waitcnt vmcnt(0)" ::: "memory");
            const unsigned og = xb_add(&bar[XB_TOP], 1u);
            const unsigned tg = og / nx;
            if (og + 1u == (tg + 1u) * nx) xb_add(&bar[XB_TOPGEN], 1u);
            else XB_SPIN(xb_ld(&bar[XB_TOPGEN]) == tg, bar);
            __builtin_amdgcn_fence(__ATOMIC_ACQUIRE, "agent");
            xb_add(&bar[XB_XGEN(b.x)], 1u);
            asm volatile("s_waitcnt vmcnt(0)" ::: "memory");
        } else {
            XB_SPIN(xb_ld(&bar[XB_XGEN(b.x)]) == gen, bar);
            __builtin_amdgcn_fence(__ATOMIC_ACQUIRE, "agent");
            asm volatile("s_waitcnt vmcnt(0)" ::: "memory");
        }
    }
    __syncthreads();
}

constexpr int NSTEPS = 20;
__device__ __forceinline__ int step_of(int it) { return it <= 2 ? it : (it == 3 ? 19 : it - 1); }
__device__ __forceinline__ bool step_needs_sync(int st) { return st != 11 && st != 12 && st != 19; }
__device__ __forceinline__ bool make_job(const Params& p, int st, GemmJob& j) {
    unsigned char* ws = p.ws; bf16_t* H = (bf16_t*)(ws + WS_H);
    j.bsA = 0; j.bsB = 0; j.bsO = 0; j.xp = p.in[0]; j.xs = p.in[1]; j.nB = 1; j.ldc = 1024; j.ssp = nullptr; j.xb = H; j.gather = 0; j.rs16 = 0; j.cw = nullptr; j.cb = nullptr; j.uh = nullptr;
    float* SSP = (float*)(ws + WS_SSP); float* RSTD = (float*)(ws + WS_RSTD);
    const int layer = st >= 15 ? 1 : 0;
    if (st == 1) { j.A = (const bf16_t*)(ws + WS_DFTC); j.B = (const bf16_t*)(ws + WS_HS); j.lda = 256; j.ldb = 1024; j.bsB = 256; j.K = 256; j.nM = 1; j.nN = NBATCH * 9; j.nB = 4; j.emode = EM_Y1T; j.O = ws + WS_Y1T; j.ldc = SEQH; return true; }
    if (st == 2) { j.A = (const bf16_t*)(ws + WS_A2); j.B = (const bf16_t*)(ws + WS_Y1T); j.lda = 1280; j.ldb = SEQH; j.bsB = (long)1024 * SEQH; j.K = 1280; j.nM = 4; j.nN = 4; j.nB = NBATCH; j.emode = EM_PLAIN; j.O = ws + WS_F; j.bsO = (long)2048 * 1024; j.ldc = 2048; return true; }
    if (st == 19) { j.A = (const bf16_t*)(ws + WS_A2) + (size_t)1024 * 1280; j.B = (const bf16_t*)(ws + WS_Y1T) + 1280; j.lda = 1024; j.ldb = SEQH; j.bsB = (long)1024 * SEQH; j.K = 1024; j.nM = 4; j.nN = 4; j.nB = NBATCH; j.emode = EM_PLAIN; j.O = (bf16_t*)(ws + WS_F) + 1024; j.bsO = (long)2048 * 1024; j.ldc = 2048; return true; }
    if (st == 3) { j.ssp = SSP; j.A = (const bf16_t*)(ws + WS_F); j.B = (const bf16_t*)(ws + WS_WFO); j.lda = 1024; j.ldb = 1024; j.K = 1024; j.nM = T / 256; j.nN = 4; j.emode = EM_RES0; j.O = p.out; return true; }
    if (st == 4 || st == 15) {
        j.A = H; j.B = (const bf16_t*)(ws + (layer ? WS_WUP1 : WS_WUP0)); j.lda = 1024; j.ldb = 1024; j.K = 1024; j.nM = 3; j.nN = FF2 / 256; j.emode = EM_PLAIN; j.O = ws + WS_UH; j.ldc = FF2; j.ssp = SSP; j.rs16 = 1; j.gather = 1; return true; }
    if (st == 5 || st == 16) {
        j.A = H; j.B = (const bf16_t*)(ws + (layer ? WS_WUP1 : WS_WUP0)); j.lda = 1024; j.ldb = 1024; j.K = 1024; j.nM = T / 256; j.nN = FF2 / 256; j.emode = EM_GATE; j.O = ws + WS_G; j.ldc = FF; j.ssp = RSTD;
        j.cw = p.in[12] + (size_t)layer * 3 * FF2; j.cb = p.in[13] + (size_t)layer * FF2; j.uh = (const bf16_t*)(ws + WS_UH); return true; }
    if (st == 6 || st == 17) { j.ssp = SSP; j.A = (const bf16_t*)(ws + WS_G); j.B = (const bf16_t*)(ws + (layer ? WS_WDN1 : WS_WDN0)); j.lda = FF; j.ldb = FF; j.K = FF; j.nM = T / 256; j.nN = 4; j.emode = EM_RES; j.O = p.out; return true; }
    if (st == 8) { j.A = H; j.B = (const bf16_t*)(ws + WS_WIN); j.lda = 1024; j.ldb = 1024; j.K = 1024; j.nM = T / 256; j.nN = 2; j.emode = EM_PLAIN; j.O = ws + WS_AA; j.ldc = 512; j.ssp = RSTD; return true; }
    if (st == 10) { j.A = (const bf16_t*)(ws + WS_CQ); j.B = (const bf16_t*)(ws + WS_WUQ); j.lda = 256; j.ldb = 256; j.K = 256; j.nM = T / 256; j.nN = 6; j.emode = EM_PLAIN; j.O = ws + WS_Q; j.ldc = 1536; return true; }
    if (st == 11) { j.A = (const bf16_t*)(ws + WS_CKV); j.B = (const bf16_t*)(ws + WS_WK); j.lda = 128; j.ldb = 128; j.K = 128; j.nM = T / 256; j.nN = 4; j.emode = EM_PLAIN; j.O = ws + WS_KN; return true; }
    if (st == 12) { j.A = (const bf16_t*)(ws + WS_WV); j.B = (const bf16_t*)(ws + WS_CKV); j.lda = 128; j.ldb = 128; j.K = 128; j.nM = 4; j.nN = T / 256; j.emode = EM_VT; j.O = ws + WS_VT; j.ldc = 2048; return true; }
    if (st == 14) { j.ssp = SSP; j.A = (const bf16_t*)(ws + WS_O); j.B = (const bf16_t*)(ws + WS_WO); j.lda = 1024; j.ldb = 1024; j.K = 1024; j.nM = T / 256; j.nN = 4; j.emode = EM_RES; j.O = p.out; return true; }
    return false;
}
__global__ void __launch_bounds__(NTHREADS, 2) mega(Params p) {
    extern __shared__ __attribute__((aligned(16))) unsigned char smem[];
    LAS unsigned char* lds = (LAS unsigned char*)smem;
    unsigned char* ws = p.ws;
    bf16_t* H = (bf16_t*)(ws + WS_H);
    XcdBarrier xbar; xbar.bar = (unsigned*)(ws + WS_BAR); xbar.x = 0; xbar.st = (volatile LAS unsigned*)(lds + LDS_XB);
    if (p.coop) {
        if (threadIdx.x < 4) ((LAS unsigned*)(lds + LDS_XB))[threadIdx.x] = 0u;
        __syncthreads();
        xbar = xcd_barrier_post((unsigned*)(ws + WS_BAR), (volatile LAS unsigned*)(lds + LDS_XB));
    }
    bool first_sync = true;
    for (int it = p.ph_lo; it < p.ph_hi; ++it) {
        const int st = step_of(it);
        if (it > p.ph_lo && p.coop && step_needs_sync(st)) {
            if (first_sync) { cg::this_grid().sync(); first_sync = false; }
            else xcd_barrier(xbar);
        }
        if (st == 4 || st == 7 || st == 15) {
            const float* SSP = (const float*)(ws + WS_SSP); float* RSTD = (float*)(ws + WS_RSTD);
            const int nskip = (st != 7 && (int)gridDim.x > 132) ? 66 : 0;
            for (int row = (obid() - nskip) * NTHREADS + otid(); row < T && obid() >= nskip; row += ((int)gridDim.x - nskip) * NTHREADS) {
                const f32x4* q4 = (const f32x4*)(SSP + (size_t)row * 16); const f32x4 a = q4[0], b = q4[1], c = q4[2], d = q4[3];
                const float ss = ((a[0] + a[1]) + (a[2] + a[3])) + ((b[0] + b[1]) + (b[2] + b[3])) + ((c[0] + c[1]) + (c[2] + c[3])) + ((d[0] + d[1]) + (d[2] + d[3]));
                RSTD[row] = rsqrtf(ss * (1.0f / D) + EPS); }
        }
        GemmJob job;
        if (make_job(p, st, job)) { gemm_phase(lds, job); continue; }
        if (st == 0) {
            float* tile = (float*)smem;
            for (int w = 0; w < 10; ++w) {
                const float* src; const float* ksc = nullptr; float wsc = 1.0f; int K, N, ld, Np, cm = 0; size_t dsto;
                switch (w) {
                    case 0: src = p.in[3]; K = 1024; N = 1024; ld = 1024; Np = 1024; dsto = WS_WFO; break;
                    case 1: src = p.in[4]; K = 1024; N = 416; ld = 416; Np = 512; dsto = WS_WIN; ksc = p.in[2] + D; break;
                    case 2: src = p.in[7]; K = 256; N = 1536; ld = 1536; Np = 1536; dsto = WS_WUQ; wsc = 0.10206207261596577f * 1.4426950408889634f; break;
                    case 3: src = p.in[8]; K = 128; N = 1024; ld = 2048; Np = 1024; cm = 1; dsto = WS_WK; break;
                    case 4: src = p.in[8]; K = 128; N = 1024; ld = 2048; Np = 1024; cm = 2; dsto = WS_WV; break;
                    case 5: src = p.in[9]; K = 1024; N = 1024; ld = 1024; Np = 1024; dsto = WS_WO; break;
                    case 6: src = p.in[11]; K = 1024; N = FF2; ld = FF2; Np = FF2; dsto = WS_WUP0; ksc = p.in[10]; cm = 3; break;
                    case 7: src = p.in[11] + (size_t)1024 * FF2; K = 1024; N = FF2; ld = FF2; Np = FF2; dsto = WS_WUP1; ksc = p.in[10] + D; cm = 3; break;
                    case 8: src = p.in[14]; K = FF; N = 1024; ld = 1024; Np = 1024; dsto = WS_WDN0; break;
                    default: src = p.in[14] + (size_t)FF * 1024; K = FF; N = 1024; ld = 1024; Np = 1024; dsto = WS_WDN1; break;
                }
                transpose_w(src, K, N, ld, (bf16_t*)(ws + dsto), Np, cm, ksc, wsc, tile);
            }
            gen_tables(p);
        }
        if (st == 0 || st == 18) { rmsnorm_pass(p, st == 0 ? 0 : 2, st == 0 ? p.in[2] : p.in[15], H); continue; }
        if (st == 9) { mla_mid_pass(p); continue; }
        if (st == 13) { attn_phase(p, lds); continue; }
    }
}

#ifndef N_LAUNCH_MODE
#define N_LAUNCH_MODE 1
#endif
extern "C" void kernel_launch(void* const* d_in, const int* in_sizes, int n_in, void* d_out, int out_size, void* d_ws, size_t ws_size, hipStream_t stream) {
    static int grid = 0;
    if (grid == 0) {
        if (n_in != 16 || out_size != T * D || ws_size < WS_END) { fprintf(stderr, "kernel_launch: unexpected shapes n_in %d out %d ws %zu (need %zu)\n", n_in, out_size, ws_size, (size_t)WS_END); grid = -1; return; }
        int dev = 0, cus = 0, per_cu = 0;
        hipGetDevice(&dev); hipDeviceGetAttribute(&cus, hipDeviceAttributeMultiprocessorCount, dev);
        if (hipFuncSetAttribute((const void*)mega, hipFuncAttributeMaxDynamicSharedMemorySize, LDS_BYTES) != hipSuccess) { fprintf(stderr, "kernel_launch: hipFuncSetAttribute failed\n"); grid = -1; return; }
        if (hipOccupancyMaxActiveBlocksPerMultiprocessor(&per_cu, (const void*)mega, NTHREADS, LDS_BYTES) != hipSuccess || per_cu < 1) { fprintf(stderr, "kernel_launch: occupancy query says %d\n", per_cu); per_cu = 1; }
        (void)hipGetLastError();
        grid = cus * 1;
    }
    if (grid < 0) return;
    Params p{};
    for (int i = 0; i < 16; ++i) p.in[i] = (const float*)d_in[i];
    p.out = (float*)d_out; p.ws = (unsigned char*)d_ws;
#if N_LAUNCH_MODE == 1
    if (hipMemsetAsync((char*)d_ws + WS_BAR, 0, XCD_BAR_WORDS * 4, stream) != hipSuccess) { fprintf(stderr, "kernel_launch: memset of barrier words failed\n"); return; }
    p.ph_lo = 0; p.ph_hi = NSTEPS; p.coop = 1;
    void* args[] = {&p};
    hipError_t e = hipLaunchCooperativeKernel((const void*)mega, dim3(grid), dim3(NTHREADS), args, LDS_BYTES, stream);
    if (e != hipSuccess) fprintf(stderr, "cooperative launch failed: %s (grid %d)\n", hipGetErrorString(e), grid);
#else
    for (int ph = 0; ph < NSTEPS; ++ph) {
        p.ph_lo = ph; p.ph_hi = ph + 1; p.coop = 0;
        hipLaunchKernelGGL(mega, dim3(grid), dim3(NTHREADS), LDS_BYTES, stream, p);
    }
#endif
}
```
